# Optimizing an MI355X kernel written in HIP

```python
import jax
import jax.numpy as jnp
from jax import lax
import numpy as np

D_MODEL = 1024
BATCH = 8
SEQ = 2048
DEPTH = 4

N_META = 16
D_MIX = 2 * D_MODEL
W_GRP = D_MIX // 4
CONV_K = 4
D_FF = ((8 * D_MODEL // 3 + 127) // 128) * 128
EPS = 1e-6
CHUNK = 64
LEAD_PAD = CHUNK - N_META

LRU_HEAD_DIM = 64
LRU_HEADS = W_GRP // LRU_HEAD_DIM
LRU_C = 8.0

GDN_HEAD_DIM = 128
GDN_HEADS = W_GRP // GDN_HEAD_DIM

SSD_HEAD_DIM = 64
SSD_HEADS = W_GRP // SSD_HEAD_DIM
SSD_GROUPS = 2
SSD_STATE = 128

S5_GROUP_CH = 16
S5_GROUPS = W_GRP // S5_GROUP_CH
S5_STATE = 64

IN_SPLITS = (W_GRP, W_GRP, 3 * W_GRP, W_GRP, GDN_HEADS, GDN_HEADS,
             W_GRP, W_GRP + 2 * SSD_GROUPS * SSD_STATE, SSD_HEADS, W_GRP)
D_IN = sum(IN_SPLITS)

kernel_name = "hymba_style_parallel_hybrid_trunk"

F32 = jnp.float32


def rms_norm(x, g):
    xf = x.astype(F32)
    y = xf * lax.rsqrt(jnp.mean(xf * xf, axis=-1, keepdims=True) + EPS)
    return (y * g.astype(F32)).astype(x.dtype)


def l2_norm(x):
    return x * lax.rsqrt(jnp.sum(x * x, axis=-1, keepdims=True) + EPS)


def causal_dwconv(x, w):
    ch = x.shape[-1]
    return lax.conv_general_dilated(
        x, w[:, None, :].astype(x.dtype), window_strides=(1,),
        padding=[(w.shape[0] - 1, 0)], dimension_numbers=("NWC", "WIO", "NWC"),
        feature_group_count=ch)


def swiglu(x, w_gate, w_up, w_down):
    return (jax.nn.silu(x @ w_gate) * (x @ w_up)) @ w_down


def front_pad(t, n):
    return jnp.pad(t, [(0, 0), (n, 0)] + [(0, 0)] * (t.ndim - 2))


def _linear_combine(e1, e2):
    a1, b1 = e1
    a2, b2 = e2
    return a1 * a2, a2 * b1 + b2


def _complex_linear_combine(e1, e2):
    a1r, a1i, b1r, b1i = e1
    a2r, a2i, b2r, b2i = e2
    return (a1r * a2r - a1i * a2i, a1r * a2i + a1i * a2r,
            a2r * b1r - a2i * b1i + b2r, a2r * b1i + a2i * b1r + b2i)


def rglru_mixer(u_x, u_gate, conv_w, conv_b, w_a, b_a, w_i, b_i, lam, norm_g):
    bsz, t, _ = u_x.shape
    xc = (causal_dwconv(u_x, conv_w) + conv_b).astype(F32)
    xh = xc.reshape(bsz, t, LRU_HEADS, LRU_HEAD_DIM)
    r = jax.nn.sigmoid(jnp.einsum("btsi,sij->btsj", xh, w_a.astype(F32)).reshape(bsz, t, W_GRP) + b_a)
    ig = jax.nn.sigmoid(jnp.einsum("btsi,sij->btsj", xh, w_i.astype(F32)).reshape(bsz, t, W_GRP) + b_i)
    log_a = -LRU_C * r * jax.nn.softplus(-lam.astype(F32))
    a = jnp.exp(log_a)
    b = jnp.sqrt(-jnp.expm1(2.0 * log_a)) * (ig * xc)
    _, h = lax.associative_scan(_linear_combine, (a, b), axis=1)
    y = jax.nn.gelu(u_gate.astype(F32)) * h
    return rms_norm(y, norm_g)


def chunk_gated_delta_rule(q, k, v, beta, g):
    bsz, tp, nh, dk = q.shape
    dv = v.shape[-1]
    nc = tp // CHUNK

    def blk(z):
        z = z.reshape((bsz, nc, CHUNK) + z.shape[2:])
        return jnp.moveaxis(jnp.moveaxis(z, 1, 0), 2, 3)

    q, k, v, beta, g = (blk(z) for z in (q, k, v, beta, g))
    g = jnp.cumsum(g, axis=-1)
    incl = jnp.tril(jnp.ones((CHUNK, CHUNK), dtype=bool))
    strict = jnp.tril(jnp.ones((CHUNK, CHUNK), dtype=bool), -1)
    decay = jnp.exp(jnp.where(incl, g[..., :, None] - g[..., None, :], -jnp.inf))
    k_beta = k * beta[..., None]
    lmat = jnp.where(strict, jnp.einsum("nbhcd,nbhsd->nbhcs", k_beta, k) * decay, 0.0)
    eye = jnp.eye(CHUNK, dtype=F32)
    rhs = jnp.concatenate([v * beta[..., None], k_beta * jnp.exp(g)[..., None]], axis=-1)
    sol = lax.linalg.triangular_solve(eye + lmat, rhs, left_side=True, lower=True,
                                      unit_diagonal=True)
    u, w = sol[..., :dv], sol[..., dv:]
    attn = jnp.einsum("nbhcd,nbhsd->nbhcs", q, k) * decay
    q_dec = q * jnp.exp(g)[..., None]
    k_dec = k * jnp.exp(g[..., -1:] - g)[..., None]
    last = jnp.exp(g[..., -1])

    def step(s, inp):
        u_n, w_n, attn_n, q_n, k_n, last_n = inp
        v_new = u_n - jnp.einsum("bhcd,bhde->bhce", w_n, s)
        o_n = jnp.einsum("bhcd,bhde->bhce", q_n, s) + jnp.einsum("bhcs,bhse->bhce", attn_n, v_new)
        s = s * last_n[..., None, None] + jnp.einsum("bhcd,bhce->bhde", k_n, v_new)
        return s, o_n

    s0 = jnp.zeros((bsz, nh, dk, dv), F32)
    _, o = lax.scan(step, s0, (u, w, attn, q_dec, k_dec, last))
    return jnp.moveaxis(o, 0, 1).transpose(0, 1, 3, 2, 4).reshape(bsz, tp, nh, dv)


def gdn_mixer(u_qkv, u_z, u_beta, u_alpha, conv_w, a_log, dt_bias, norm_g):
    bsz, t, _ = u_qkv.shape
    qkv = jax.nn.silu(causal_dwconv(u_qkv, conv_w).astype(F32))
    q, k, v = jnp.split(qkv, 3, axis=-1)
    hs = (bsz, t, GDN_HEADS, GDN_HEAD_DIM)
    q = l2_norm(q.reshape(hs)) * (GDN_HEAD_DIM ** -0.5)
    k = l2_norm(k.reshape(hs))
    v = v.reshape(hs)
    beta = jax.nn.sigmoid(u_beta.astype(F32))
    g = -jnp.exp(a_log.astype(F32)) * jax.nn.softplus(u_alpha.astype(F32) + dt_bias)
    o = chunk_gated_delta_rule(*(front_pad(z, LEAD_PAD) for z in (q, k, v, beta, g)))[:, LEAD_PAD:]
    o = rms_norm(o, norm_g) * jax.nn.silu(u_z.astype(F32).reshape(hs))
    return o.reshape(bsz, t, W_GRP)


def ssd_chunked(x, a_dt, bm, cm):
    bsz, tp, nh, hd = x.shape
    nc = tp // CHUNK
    hpg = nh // SSD_GROUPS
    x = x.reshape(bsz, nc, CHUNK, SSD_GROUPS, hpg, hd)
    a = a_dt.reshape(bsz, nc, CHUNK, SSD_GROUPS, hpg).transpose(0, 1, 3, 4, 2)
    bm = bm.reshape(bsz, nc, CHUNK, SSD_GROUPS, SSD_STATE)
    cm = cm.reshape(bsz, nc, CHUNK, SSD_GROUPS, SSD_STATE)
    a_cum = jnp.cumsum(a, axis=-1)
    incl = jnp.tril(jnp.ones((CHUNK, CHUNK), dtype=bool))
    lmat = jnp.exp(jnp.where(incl, a_cum[..., :, None] - a_cum[..., None, :], -jnp.inf))
    cb = jnp.einsum("bclgn,bcsgn->bcgls", cm, bm)
    y_diag = jnp.einsum("bcgls,bcgels,bcsgep->bclgep", cb, lmat, x)
    decay_states = jnp.exp(a_cum[..., -1:] - a_cum)
    states = jnp.einsum("bclgn,bcgel,bclgep->bcgepn", bm, decay_states, x)
    chunk_decay = jnp.exp(a_cum[..., -1])

    def step(s, inp):
        st, dec = inp
        return s * dec[..., None, None] + st, s

    _, s_in = lax.scan(step, jnp.zeros_like(states[:, 0]),
                       (jnp.moveaxis(states, 1, 0), jnp.moveaxis(chunk_decay, 1, 0)))
    s_in = jnp.moveaxis(s_in, 0, 1)
    y_off = jnp.einsum("bclgn,bcgepn,bcgel->bclgep", cm, s_in, jnp.exp(a_cum))
    return (y_diag + y_off).reshape(bsz, tp, nh, hd)


def ssd_mixer(u_z, u_xbc, u_dt, conv_w, conv_b, a_log, dt_bias, d_skip, norm_g):
    bsz, t, _ = u_z.shape
    xbc = jax.nn.silu((causal_dwconv(u_xbc, conv_w) + conv_b).astype(F32))
    xs, bm, cm = jnp.split(xbc, [W_GRP, W_GRP + SSD_GROUPS * SSD_STATE], axis=-1)
    xs = xs.reshape(bsz, t, SSD_HEADS, SSD_HEAD_DIM)
    bm = bm.reshape(bsz, t, SSD_GROUPS, SSD_STATE)
    cm = cm.reshape(bsz, t, SSD_GROUPS, SSD_STATE)
    dt = jax.nn.softplus(u_dt.astype(F32) + dt_bias)
    a = -jnp.exp(a_log.astype(F32))
    y = ssd_chunked(*(front_pad(z, LEAD_PAD) for z in (xs * dt[..., None], dt * a, bm, cm)))[:, LEAD_PAD:]
    y = y + d_skip[:, None] * xs
    gs = (bsz, t, SSD_GROUPS, W_GRP // SSD_GROUPS)
    y = y.reshape(gs) * jax.nn.silu(u_z.astype(F32).reshape(gs))
    y = rms_norm(y, norm_g.reshape(SSD_GROUPS, W_GRP // SSD_GROUPS))
    return y.reshape(bsz, t, W_GRP)


def s5_mixer(u, a_re, a_im, log_dt, b_re, b_im, c_re, c_im, d_skip, w_glu, norm_g):
    bsz, t, _ = u.shape
    uf = u.astype(F32)
    ug = uf.reshape(bsz, t, S5_GROUPS, S5_GROUP_CH)
    lam_re = jnp.minimum(a_re.astype(F32), -1e-4)
    lam_im = a_im.astype(F32)
    dt = jnp.exp(log_dt.astype(F32))[:, None]
    mag = jnp.exp(dt * lam_re)
    ab_re = mag * jnp.cos(dt * lam_im)
    ab_im = mag * jnp.sin(dt * lam_im)
    den = lam_re * lam_re + lam_im * lam_im
    f_re = ((ab_re - 1.0) * lam_re + ab_im * lam_im) / den
    f_im = (ab_im * lam_re - (ab_re - 1.0) * lam_im) / den
    bb_re = f_re[..., None] * b_re - f_im[..., None] * b_im
    bb_im = f_re[..., None] * b_im + f_im[..., None] * b_re
    bu_re = jnp.einsum("btgi,gpi->tbgp", ug, bb_re)
    bu_im = jnp.einsum("btgi,gpi->tbgp", ug, bb_im)
    shp = (t, 1, S5_GROUPS, S5_STATE)
    _, _, s_re, s_im = lax.associative_scan(
        _complex_linear_combine,
        (jnp.broadcast_to(ab_re, shp), jnp.broadcast_to(ab_im, shp), bu_re, bu_im), axis=0)
    y = jnp.einsum("tbgp,gip->btgi", s_re, c_re) - jnp.einsum("tbgp,gip->btgi", s_im, c_im)
    y = y.reshape(bsz, t, W_GRP) + d_skip * uf
    y = jax.nn.gelu(y)
    y = y * jax.nn.sigmoid(y @ w_glu.astype(F32))
    return rms_norm(y, norm_g)


def hybrid_mixer(h, w_in, w_out, lru_p, gdn_p, ssd_p, s5_p):
    proj = h @ w_in
    (a_x, a_gate, b_qkv, b_z, b_beta, b_alpha, c_z, c_xbc, c_dt, d_u) = jnp.split(
        proj, np.cumsum(IN_SPLITS)[:-1].tolist(), axis=-1)
    y_a = rglru_mixer(a_x, a_gate, *lru_p)
    y_b = gdn_mixer(b_qkv, b_z, b_beta, b_alpha, *gdn_p)
    y_c = ssd_mixer(c_z, c_xbc, c_dt, *ssd_p)
    y_d = s5_mixer(d_u, *s5_p)
    y = jnp.concatenate([y_a, y_b, y_c, y_d], axis=-1).astype(h.dtype)
    return y @ w_out


def setup_inputs(seed: int = 0) -> dict:
    key = jax.random.key(seed)
    ks = iter(jax.random.split(key, 64))
    L = DEPTH

    def nrm(shape, scale):
        return jax.random.normal(next(ks), shape, F32) * scale

    def gain(shape):
        return 1.0 + 0.02 * jax.random.normal(next(ks), shape, F32)

    def unif(shape, lo, hi):
        return jax.random.uniform(next(ks), shape, F32, lo, hi)

    def dt_bias(shape):
        dt = jnp.exp(unif(shape, float(np.log(1e-3)), float(np.log(1e-1))))
        return dt + jnp.log(-jnp.expm1(-dt))

    a0 = unif((L, W_GRP), 0.9, 0.999) ** (1.0 / LRU_C)
    xbc_w = W_GRP + 2 * SSD_GROUPS * SSD_STATE
    return {
        "x": nrm((BATCH, SEQ, D_MODEL), 1.0),
        "meta_tokens": nrm((N_META, D_MODEL), 1.0),
        "ffn1_norm": gain((L, D_MODEL)),
        "ffn1_w_gate": nrm((L, D_MODEL, D_FF), D_MODEL ** -0.5),
        "ffn1_w_up": nrm((L, D_MODEL, D_FF), D_MODEL ** -0.5),
        "ffn1_w_down": nrm((L, D_FF, D_MODEL), D_FF ** -0.5),
        "mix_norm": gain((L, D_MODEL)),
        "w_in": nrm((L, D_MODEL, D_IN), D_MODEL ** -0.5),
        "w_out": nrm((L, D_MIX, D_MODEL), D_MIX ** -0.5),
        "lru_conv_w": nrm((L, CONV_K, W_GRP), CONV_K ** -0.5),
        "lru_conv_b": nrm((L, W_GRP), 0.02),
        "lru_w_a": nrm((L, LRU_HEADS, LRU_HEAD_DIM, LRU_HEAD_DIM), LRU_HEAD_DIM ** -0.5),
        "lru_b_a": nrm((L, W_GRP), 0.02),
        "lru_w_i": nrm((L, LRU_HEADS, LRU_HEAD_DIM, LRU_HEAD_DIM), LRU_HEAD_DIM ** -0.5),
        "lru_b_i": nrm((L, W_GRP), 0.02),
        "lru_lambda": jnp.log(a0) - jnp.log1p(-a0),
        "lru_norm": gain((L, W_GRP)),
        "gdn_conv_w": nrm((L, CONV_K, 3 * W_GRP), CONV_K ** -0.5),
        "gdn_a_log": jnp.log(unif((L, GDN_HEADS), 1.0, 16.0)),
        "gdn_dt_bias": dt_bias((L, GDN_HEADS)),
        "gdn_norm": gain((L, GDN_HEAD_DIM)),
        "ssd_conv_w": nrm((L, CONV_K, xbc_w), CONV_K ** -0.5),
        "ssd_conv_b": nrm((L, xbc_w), 0.02),
        "ssd_a_log": jnp.log(unif((L, SSD_HEADS), 1.0, 16.0)),
        "ssd_dt_bias": dt_bias((L, SSD_HEADS)),
        "ssd_d": gain((L, SSD_HEADS)),
        "ssd_norm": gain((L, W_GRP)),
        "s5_a_re": -0.5 + nrm((L, S5_GROUPS, S5_STATE), 0.01),
        "s5_a_im": jnp.pi * jnp.arange(S5_STATE, dtype=F32) + nrm((L, S5_GROUPS, S5_STATE), 0.01),
        "s5_log_dt": unif((L, S5_GROUPS), float(np.log(1e-3)), float(np.log(1e-1))),
        "s5_b_re": nrm((L, S5_GROUPS, S5_STATE, S5_GROUP_CH), (2 * S5_GROUP_CH) ** -0.5),
        "s5_b_im": nrm((L, S5_GROUPS, S5_STATE, S5_GROUP_CH), (2 * S5_GROUP_CH) ** -0.5),
        "s5_c_re": nrm((L, S5_GROUPS, S5_GROUP_CH, S5_STATE), (2 * S5_STATE) ** -0.5),
        "s5_c_im": nrm((L, S5_GROUPS, S5_GROUP_CH, S5_STATE), (2 * S5_STATE) ** -0.5),
        "s5_d": nrm((L, W_GRP), 1.0),
        "s5_w_glu": nrm((L, W_GRP, W_GRP), W_GRP ** -0.5),
        "s5_norm": gain((L, W_GRP)),
        "ffn2_norm": gain((L, D_MODEL)),
        "ffn2_w_gate": nrm((L, D_MODEL, D_FF), D_MODEL ** -0.5),
        "ffn2_w_up": nrm((L, D_MODEL, D_FF), D_MODEL ** -0.5),
        "ffn2_w_down": nrm((L, D_FF, D_MODEL), D_FF ** -0.5),
        "final_norm": gain((D_MODEL,)),
    }


def reference(x, meta_tokens, ffn1_norm, ffn1_w_gate, ffn1_w_up, ffn1_w_down, mix_norm, w_in, w_out,
              lru_conv_w, lru_conv_b, lru_w_a, lru_b_a, lru_w_i, lru_b_i, lru_lambda, lru_norm,
              gdn_conv_w, gdn_a_log, gdn_dt_bias, gdn_norm,
              ssd_conv_w, ssd_conv_b, ssd_a_log, ssd_dt_bias, ssd_d, ssd_norm,
              s5_a_re, s5_a_im, s5_log_dt, s5_b_re, s5_b_im, s5_c_re, s5_c_im, s5_d, s5_w_glu, s5_norm,
              ffn2_norm, ffn2_w_gate, ffn2_w_up, ffn2_w_down, final_norm):
    bsz = x.shape[0]
    meta = jnp.broadcast_to(meta_tokens.astype(x.dtype)[None], (bsz, N_META, D_MODEL))
    h = jnp.concatenate([meta, x], axis=1)
    for l in range(DEPTH):
        h = h + 0.5 * swiglu(rms_norm(h, ffn1_norm[l]), ffn1_w_gate[l], ffn1_w_up[l], ffn1_w_down[l])
        lru_p = (lru_conv_w[l], lru_conv_b[l], lru_w_a[l], lru_b_a[l], lru_w_i[l], lru_b_i[l],
                 lru_lambda[l], lru_norm[l])
        gdn_p = (gdn_conv_w[l], gdn_a_log[l], gdn_dt_bias[l], gdn_norm[l])
        ssd_p = (ssd_conv_w[l], ssd_conv_b[l], ssd_a_log[l], ssd_dt_bias[l], ssd_d[l], ssd_norm[l])
        s5_p = (s5_a_re[l], s5_a_im[l], s5_log_dt[l], s5_b_re[l], s5_b_im[l], s5_c_re[l], s5_c_im[l],
                s5_d[l], s5_w_glu[l], s5_norm[l])
        h = h + hybrid_mixer(rms_norm(h, mix_norm[l]), w_in[l], w_out[l], lru_p, gdn_p, ssd_p, s5_p)
        h = h + 0.5 * swiglu(rms_norm(h, ffn2_norm[l]), ffn2_w_gate[l], ffn2_w_up[l], ffn2_w_down[l])
    return rms_norm(h, final_norm)[:, N_META:]
```

```cpp
#include <hip/hip_runtime.h>
#include <hip/hip_cooperative_groups.h>
#include <cstdio>
namespace cg = cooperative_groups;

#define LAS __attribute__((address_space(3)))
typedef unsigned short bf16_t;
typedef short bf16x8 __attribute__((ext_vector_type(8)));
typedef float f32x4 __attribute__((ext_vector_type(4)));
typedef float f32x2 __attribute__((ext_vector_type(2)));
typedef unsigned u32x4 __attribute__((ext_vector_type(4)));
typedef unsigned u32x2 __attribute__((ext_vector_type(2)));

constexpr int DM = 1024, NB = 8, SEQ = 2048, NL = 4, NMETA = 16, TP = 2112, MP = NB * TP  , LEAD = 48;
constexpr int DFF = 2816, DIN = 5136, NPJ = 5376  , PJ_LD = 5120, DMIX = 2048, WG = 512;
constexpr int NTHREADS = 512;
constexpr int LRU_SEG = 11, LRU_HK = 6;
constexpr int LDS_BYTES = 160 * 1024;
#ifndef MIXREP
#define MIXREP 1
#endif
#ifndef YMASK
#define YMASK 15
#endif
__device__ __forceinline__ bool ymask_on(int bit) { int m = YMASK; asm volatile("" : "+s"(m)); return ((m >> bit) & 1) != 0; }

enum { I_X = 0, I_META, I_F1N, I_F1G, I_F1U, I_F1D, I_MIXN, I_WIN, I_WOUT,
       I_LCW, I_LCB, I_LWA, I_LBA, I_LWI, I_LBI, I_LLAM, I_LNORM,
       I_GCW, I_GALOG, I_GDTB, I_GNORM,
       I_SCW, I_SCB, I_SALOG, I_SDTB, I_SD, I_SNORM,
       I_5ARE, I_5AIM, I_5LDT, I_5BRE, I_5BIM, I_5CRE, I_5CIM, I_5D, I_5GLU, I_5NORM,
       I_F2N, I_F2G, I_F2U, I_F2D, I_FINN, N_INPUTS };

constexpr size_t WS_H = 0;
constexpr size_t WS_XN = WS_H + (size_t)MP * DM * 4;
constexpr size_t WS_W = WS_XN + (size_t)MP * DM * 2;
constexpr size_t W_GU1 = 0;
constexpr size_t W_DN1 = W_GU1 + (size_t)2 * DFF * DM;
constexpr size_t W_IN = W_DN1 + (size_t)DM * DFF;
constexpr size_t W_OUT = W_IN + (size_t)NPJ * DM;
constexpr size_t W_GU2 = W_OUT + (size_t)DM * DMIX;
constexpr size_t W_DN2 = W_GU2 + (size_t)2 * DFF * DM;
constexpr size_t W_GLU = W_DN2 + (size_t)DM * DFF;
constexpr size_t W_ELEMS = W_GLU + (size_t)WG * WG;
constexpr size_t WS_R = WS_W + W_ELEMS * 2;
constexpr size_t WS_ACT = WS_R;
constexpr size_t WS_PROJ = WS_R;
constexpr size_t WS_SM = WS_PROJ + (size_t)MP * PJ_LD * 2;
constexpr size_t WS_Y = WS_SM + (size_t)MP * 16 * 4;
constexpr size_t WS_YP = WS_Y + (size_t)MP * DMIX * 2;
constexpr size_t WS_BAR = WS_YP + (size_t)MP * WG * 2;
constexpr size_t WS_PART = WS_BAR + 16384;
constexpr size_t WS_CAR = WS_PART + (size_t)11 * 512 * DM * 4;
constexpr size_t WS_SSQ = WS_CAR + (size_t)NB * 11 * 2 * WG * 4;
constexpr size_t WS_TA = WS_SSQ + (size_t)MP * 16 * 4;
constexpr size_t WS_FLAG = WS_TA + (size_t)32 * 33 * 2 * 4096 * 2;
constexpr size_t WS_END = WS_FLAG + 8192;

struct Params { const float* in[N_INPUTS]; float* out; unsigned char* ws; };

typedef __bf16 bf16x2_t __attribute__((ext_vector_type(2)));
__device__ __forceinline__ unsigned cvt_pk_bf16(float lo, float hi) { const f32x2 v = {lo, hi}; const bf16x2_t b = __builtin_convertvector(v, bf16x2_t); return __builtin_bit_cast(unsigned, b); }
__device__ __forceinline__ float bf2f(bf16_t b) { return __uint_as_float(((unsigned)b) << 16); }
__device__ __forceinline__ bf16_t f2bf(float f) { return (bf16_t)(cvt_pk_bf16(f, 0.f) & 0xffffu); }
__device__ __forceinline__ float sigmoidf_(float x) { return __builtin_amdgcn_rcpf(1.0f + __expf(-x)); }
__device__ __forceinline__ float siluf_(float x) { return x * __builtin_amdgcn_rcpf(1.0f + __expf(-x)); }
__device__ __forceinline__ float softplusf_(float x) { const float e = __expf(x); return x > 20.f ? x : (x < -15.f ? e : __logf(1.0f + e)); }
__device__ __forceinline__ float neg_expm1(float x) { const float ser = -x * (1.0f + x * 0.5f * (1.0f + x * (1.0f / 3.0f) * (1.0f + x * 0.25f * (1.0f + x * 0.2f * (1.0f + x * (1.0f / 6.0f)))))); return x > -0.5f ? ser : 1.0f - __expf(x); }
__device__ __forceinline__ float gelu_tanh(float x) { const float u = 0.7978845608028654f * (x + 0.044715f * x * x * x); return x * __builtin_amdgcn_rcpf(1.0f + __expf(-2.0f * u)); }

__device__ __forceinline__ int opaque_tid(int wv) { int t; asm volatile("v_mbcnt_lo_u32_b32 %0, -1, 0\n\tv_mbcnt_hi_u32_b32 %0, -1, %0" : "=v"(t)); return (wv << 6) | t; }
__device__ __forceinline__ int opaque_v0() { int z = 0; asm volatile("" : "+v"(z)); return z; }
__device__ __forceinline__ int opaque_s(int v) { asm volatile("" : "+s"(v)); return v; }

__device__ __forceinline__ float shx(float v, int mask, int lane) { return __int_as_float(__builtin_amdgcn_ds_bpermute((lane ^ mask) << 2, __float_as_int(v))); }
__device__ __forceinline__ float shidx(float v, int src) { return __int_as_float(__builtin_amdgcn_ds_bpermute(src << 2, __float_as_int(v))); }

namespace pg8 {
constexpr int BM = 256, BK = 64, HALF = 128, HTB = HALF * BK * 2, STAGE_BYTES = 8 * HTB, NXCD = 8, WGM = 8;
__host__ __device__ __forceinline__ int lds_byte(int r, int c) { const int st = (r >> 4) * 2 + (c >> 5), rr = r & 15, cc = c & 31, ob = rr * 64 + cc * 2; return st * 1024 + (ob ^ (((ob >> 9) & 1) << 5)); }
__host__ __device__ __forceinline__ void stage_rc(int b, int& R, int& C) { const int st = b / 1024, sb = b % 1024, swz = sb ^ (((sb >> 9) & 1) << 5); R = (st >> 1) * 16 + swz / 64; C = (st & 1) * 32 + (swz % 64) / 2; }
__host__ __device__ __forceinline__ int perm32(int rho) { const int n = rho >> 4, i = rho & 15; return 8 * (i >> 2) + 4 * n + (i & 3); }

struct Unit { int pm, pn, k0, nt; };
struct Gemm { const bf16_t* A; const bf16_t* Bt; int M, N, K; };

struct StaticOrder {
    int nMf, nN, nwg, G, c, ntk, npk, ntail;
    __device__ void init(int M, int N, int K, int G_, int c_, bool split) { const int nM = M / BM; nN = N / BM; G = G_; c = c_; ntk = K / BK;
        nMf = split ? 64 : nM; npk = split ? ntk / 4 : 0; ntail = (nM - nMf) * nN; nwg = nMf * nN; }
    __device__ bool next(int i, Unit& u) const {
        const long L = (long)i * G + c;
        if (L >= nwg) { const int idx = (int)(L - nwg); if (idx >= ntail * npk) return false;
            const int tile = idx / npk, piece = idx - tile * npk; u.pm = nMf + tile / nN; u.pn = tile % nN; u.k0 = piece * 4; u.nt = 4; return true; }
        int wgid = (int)L; { const int q = nwg / NXCD, r = nwg % NXCD, xcd = wgid % NXCD, off = wgid / NXCD; wgid = (xcd < r ? xcd * (q + 1) : r * (q + 1) + (xcd - r) * q) + off; }
        const int nig = WGM * nN, gid = wgid / nig, fm = gid * WGM, gsz = (nMf - fm) < WGM ? (nMf - fm) : WGM;
        u.pm = fm + ((wgid % nig) % gsz); u.pn = (wgid % nig) / gsz; u.k0 = 0; u.nt = ntk; return true;
    }
};

template <class Epi, class Sched>
__device__ __forceinline__ void gemm_phase(LAS unsigned char* lds, const Gemm g, const Sched& S, const Epi& E, int wv) {
    const int tid = opaque_tid(wv), wid = __builtin_amdgcn_readfirstlane(tid >> 6), lane = tid & 63, wr = wid >> 2, wc = wid & 3, fr = lane & 15, fq = lane >> 4;
    const int K = g.K;
    unsigned voffA[2], voffB[2];
#pragma unroll
    for (int i = 0; i < 2; ++i) { int R, C; stage_rc(tid * 16 + i * 8192, R, C); const int Rb = E.perm ? ((R & ~31) + perm32(R & 31)) : R;
        voffA[i] = (unsigned)(R * K + C) * 2u; voffB[i] = (unsigned)(Rb * K + C) * 2u; }
    const size_t kstep = (size_t)(BK * 2);
    const size_t hstep = (size_t)HALF * K * 2;
    const size_t tstep = 2 * hstep;
    const unsigned ldsw = (unsigned)wid * 1024u;
    const int aoff = lds_byte(wr * 64 + fr, fq * 8), boff = lds_byte(wc * 32 + fr, fq * 8);
#define PG8_SA(b, h) (((b) * 2 + (h)) * HTB)
#define PG8_SB(b, h) ((4 + (b) * 2 + (h)) * HTB)
#define PG8_STAGE(bufoff, gbase, voff) do { _Pragma("unroll") for (int _i = 0; _i < 2; ++_i) \
        __builtin_amdgcn_global_load_lds((const unsigned*)((const char*)(gbase) + (voff)[_i]), (LAS unsigned*)(lds + (bufoff) + ldsw + _i * 8192), 16, 0, 0); } while (0)
#define PG8_LDA(dst, b, h) do { _Pragma("unroll") for (int m = 0; m < 4; ++m) _Pragma("unroll") for (int k = 0; k < 2; ++k) dst[m][k] = *(const LAS bf16x8*)(lds + PG8_SA(b, h) + aoff + m * 2048 + k * 1024); } while (0)
#define PG8_LDB(dst, b, h) do { _Pragma("unroll") for (int n = 0; n < 2; ++n) _Pragma("unroll") for (int k = 0; k < 2; ++k) dst[n][k] = *(const LAS bf16x8*)(lds + PG8_SB(b, h) + boff + n * 2048 + k * 1024); } while (0)
#define PG8_MMA(ai, bj, At, Bt) do { __builtin_amdgcn_s_setprio(1); _Pragma("unroll") for (int m = 0; m < 4; ++m) _Pragma("unroll") for (int n = 0; n < 2; ++n) _Pragma("unroll") for (int k = 0; k < 2; ++k) \
        acc[ai][bj][m][n] = __builtin_amdgcn_mfma_f32_16x16x32_bf16(Bt[n][k], At[m][k], acc[ai][bj][m][n], 0, 0, 0); __builtin_amdgcn_s_setprio(0); } while (0)
#define PG8_WAIT_V(n) asm volatile("s_waitcnt vmcnt(" #n ")" ::: "memory")
#define PG8_WAIT_L(n) asm volatile("s_waitcnt lgkmcnt(" #n ")" ::: "memory")
#define PG8_BAR __builtin_amdgcn_s_barrier()
#define PG8_SCHED __builtin_amdgcn_sched_barrier(0)
    Unit cur, nxt; int ui = 0;
    if (!S.next(0, cur)) return;
    f32x4 acc[2][2][4][2];
#pragma unroll
    for (int a = 0; a < 2; ++a)
#pragma unroll
        for (int b = 0; b < 2; ++b)
#pragma unroll
            for (int m = 0; m < 4; ++m)
#pragma unroll
                for (int n = 0; n < 2; ++n) acc[a][b][m][n] = (f32x4){0.f, 0.f, 0.f, 0.f};
    bf16x8 At[4][2], B0[2][2], B1[2][2];
    const char* cA = (const char*)g.A + (size_t)cur.pm * tstep + (size_t)cur.k0 * kstep; const char* cB = (const char*)g.Bt + (size_t)cur.pn * tstep + (size_t)cur.k0 * kstep;
    PG8_STAGE(PG8_SB(0, 0), cB, voffB); PG8_STAGE(PG8_SA(0, 0), cA, voffA); PG8_STAGE(PG8_SB(0, 1), cB + hstep, voffB); PG8_STAGE(PG8_SA(0, 1), cA + hstep, voffA);
    if (wr == 1) PG8_BAR;
    PG8_WAIT_V(4); PG8_BAR;
    PG8_STAGE(PG8_SB(1, 0), cB + kstep, voffB); PG8_STAGE(PG8_SA(1, 0), cA + kstep, voffA); PG8_STAGE(PG8_SB(1, 1), cB + hstep + kstep, voffB);
    PG8_WAIT_V(6); PG8_BAR;
    for (;;) {
        const bool has_next = S.next(ui + 1, nxt);
        const char* nA = has_next ? (const char*)g.A + (size_t)nxt.pm * tstep + (size_t)nxt.k0 * kstep : cA; const char* nB = has_next ? (const char*)g.Bt + (size_t)nxt.pn * tstep + (size_t)nxt.k0 * kstep : cB;
        const int nt = cur.nt;
        for (int t = 0; t < nt; t += 2) {
            const bool last = (t == nt - 2);
            const char* a1 = cA + (size_t)(t + 1) * kstep;
            const char* a2 = last ? nA : cA + (size_t)(t + 2) * kstep; const char* b2 = last ? nB : cB + (size_t)(t + 2) * kstep;
            const char* a3 = a2 + kstep; const char* b3 = b2 + kstep;
            PG8_LDB(B0, 0, 0); PG8_SCHED; PG8_LDA(At, 0, 0); PG8_STAGE(PG8_SA(1, 1), a1 + hstep, voffA);
            PG8_WAIT_L(8); PG8_BAR; PG8_WAIT_L(0); PG8_MMA(0, 0, At, B0); PG8_BAR; PG8_SCHED;
            PG8_LDB(B1, 0, 1); PG8_STAGE(PG8_SB(0, 0), b2, voffB);
            PG8_BAR; PG8_WAIT_L(0); PG8_MMA(0, 1, At, B1); PG8_BAR;
            PG8_LDA(At, 0, 1); PG8_STAGE(PG8_SA(0, 0), a2, voffA);
            PG8_BAR; PG8_WAIT_L(0); PG8_MMA(1, 0, At, B0); PG8_BAR; PG8_SCHED;
            PG8_STAGE(PG8_SB(0, 1), b2 + hstep, voffB);
            PG8_WAIT_V(6); PG8_BAR; PG8_MMA(1, 1, At, B1); PG8_BAR;
            PG8_LDB(B0, 1, 0); PG8_SCHED; PG8_LDA(At, 1, 0); PG8_STAGE(PG8_SA(0, 1), a2 + hstep, voffA);
            PG8_WAIT_L(8); PG8_BAR; PG8_WAIT_L(0); PG8_MMA(0, 0, At, B0); PG8_BAR; PG8_SCHED;
            PG8_LDB(B1, 1, 1); PG8_STAGE(PG8_SB(1, 0), b3, voffB);
            PG8_BAR; PG8_WAIT_L(0); PG8_MMA(0, 1, At, B1); PG8_BAR;
            PG8_LDA(At, 1, 1); PG8_STAGE(PG8_SA(1, 0), a3, voffA);
            PG8_BAR; PG8_WAIT_L(0); PG8_MMA(1, 0, At, B0); PG8_BAR; PG8_SCHED;
            PG8_STAGE(PG8_SB(1, 1), b3 + hstep, voffB);
            PG8_WAIT_V(6); PG8_BAR; PG8_MMA(1, 1, At, B1); PG8_BAR;
        }
        E(acc, cur, wr, wc, fr, fq);
        if (!has_next) break;
#pragma unroll
        for (int a = 0; a < 2; ++a)
#pragma unroll
            for (int b = 0; b < 2; ++b)
#pragma unroll
                for (int m = 0; m < 4; ++m)
#pragma unroll
                    for (int n = 0; n < 2; ++n) acc[a][b][m][n] = (f32x4){0.f, 0.f, 0.f, 0.f};
        cur = nxt; cA = nA; cB = nB; ++ui;
    }
    PG8_WAIT_V(0);
    if (wr == 0) PG8_BAR;
    PG8_BAR;
#undef PG8_SA
#undef PG8_SB
#undef PG8_STAGE
#undef PG8_LDA
#undef PG8_LDB
#undef PG8_MMA
#undef PG8_WAIT_V
#undef PG8_WAIT_L
#undef PG8_BAR
#undef PG8_SCHED
}

struct Epi {
    int mode;
    bool perm;
    bf16_t* O; float* F; float scale; int ntk_full;
    __device__ __forceinline__ void operator()(const f32x4 (&acc)[2][2][4][2], const Unit& u, int wr, int wc, int fr, int fq) const {
        const int row0 = u.pm * BM + wr * 64 + fr;
        if (mode == 0) {
            const int col0 = u.pn * 128 + wc * 32 + 8 * fq;
#pragma unroll
            for (int ai = 0; ai < 2; ++ai)
#pragma unroll
                for (int m = 0; m < 4; ++m) { bf16_t* rowp = O + (size_t)(row0 + ai * HALF + m * 16) * DFF + col0;
                    float v[8];
#pragma unroll
                    for (int n = 0; n < 2; ++n)
#pragma unroll
                        for (int j = 0; j < 4; ++j) { const float gt = acc[ai][0][m][n][j], up = acc[ai][1][m][n][j]; v[n * 4 + j] = siluf_(gt) * up; }
                    u32x4 w; w.x = cvt_pk_bf16(v[0], v[1]); w.y = cvt_pk_bf16(v[2], v[3]); w.z = cvt_pk_bf16(v[4], v[5]); w.w = cvt_pk_bf16(v[6], v[7]);
                    *(u32x4*)rowp = w; }
        } else if (mode == 1) {
            const int col0 = u.pn * BM + wc * 32 + 4 * fq;
#pragma unroll
            for (int ai = 0; ai < 2; ++ai)
#pragma unroll
                for (int m = 0; m < 4; ++m) { float* rowp = F + (size_t)(row0 + ai * HALF + m * 16) * DM + col0;
#pragma unroll
                    for (int bj = 0; bj < 2; ++bj)
#pragma unroll
                        for (int n = 0; n < 2; ++n) { float* q = rowp + bj * HALF + n * 16; const f32x4 v = acc[ai][bj][m][n] * scale;
                            if (u.nt == ntk_full) { *(f32x4*)q = *(f32x4*)q + v; }
                            else { float* PART = (float*)((unsigned char*)F + (WS_PART - WS_H)); *(f32x4*)(PART + (size_t)(u.k0 >> 2) * (512 * DM) + (size_t)(row0 + ai * HALF + m * 16 - 64 * BM) * DM + (col0 + bj * HALF + n * 16)) = v; } } }
        } else {
            if (u.pn < 20) {
                const int col0 = u.pn * BM + wc * 32 + 8 * fq;
#pragma unroll
                for (int ai = 0; ai < 2; ++ai)
#pragma unroll
                    for (int m = 0; m < 4; ++m) { bf16_t* rowp = O + (size_t)(row0 + ai * HALF + m * 16) * PJ_LD + col0;
#pragma unroll
                        for (int bj = 0; bj < 2; ++bj) { const f32x4 v0 = acc[ai][bj][m][0], v1 = acc[ai][bj][m][1];
                            u32x4 w; w.x = cvt_pk_bf16(v0[0], v0[1]); w.y = cvt_pk_bf16(v0[2], v0[3]); w.z = cvt_pk_bf16(v1[0], v1[1]); w.w = cvt_pk_bf16(v1[2], v1[3]);
                            *(u32x4*)(rowp + bj * HALF) = w; } }
            } else if (wc == 0 && fq < 2) {
#pragma unroll
                for (int ai = 0; ai < 2; ++ai)
#pragma unroll
                    for (int m = 0; m < 4; ++m) { float* rowp = F + (size_t)(row0 + ai * HALF + m * 16) * 16 + 8 * fq;
                        *(f32x4*)(rowp) = acc[ai][0][m][0]; *(f32x4*)(rowp + 4) = acc[ai][0][m][1]; }
            }
        }
    }
};
}

template <int MODE>
__device__ __forceinline__ void convert_tiles(const float* src, const float* src2, bf16_t* dst, int K, int Ns, int Nd, LAS unsigned char* lds, int wi, int nw, int wv) {
    LAS float* tile = (LAS float*)lds;
    const int tid = opaque_tid(wv), tn = Nd / 64, tk = K / 64, ntile = tn * tk;
    f32x4 pre[2];
    auto issue = [&](int t) {
        const int n0 = (t % tn) * 64, k0 = (t / tn) * 64;
#pragma unroll
        for (int i = 0; i < 2; ++i) {
            const int e = tid + i * NTHREADS, kk = e >> 4, ng = (e & 15) * 4, nd = n0 + ng;
            const float* s = src; int ns = nd;
            if (MODE == 1) { const int tl = nd >> 8, w = nd & 255; if (w < 128) { ns = tl * 128 + w; } else { s = src2; ns = tl * 128 + w - 128; } }
            if (MODE == 2) { if (nd < 3072) ns = nd; else if (nd < 4608) ns = nd + 8; else if (nd < 5120) ns = nd + 16; else if (nd < 5128) ns = nd - 2048; else if (nd < 5136) ns = nd - 512; else ns = -1; }
            pre[i] = (f32x4){0.f, 0.f, 0.f, 0.f};
            if (ns >= 0) pre[i] = *(const f32x4*)(s + (size_t)(k0 + kk) * Ns + ns);
        }
    };
    if (wi < ntile) issue(wi);
    for (int t = wi; t < ntile; t += nw) {
        const int n0 = (t % tn) * 64, k0 = (t / tn) * 64;
#pragma unroll
        for (int i = 0; i < 2; ++i) { const int e = tid + i * NTHREADS, kk = e >> 4, ng = (e & 15) * 4;
            tile[kk * 65 + ng + 0] = pre[i][0]; tile[kk * 65 + ng + 1] = pre[i][1]; tile[kk * 65 + ng + 2] = pre[i][2]; tile[kk * 65 + ng + 3] = pre[i][3]; }
        if (t + nw < ntile) issue(t + nw);
        __syncthreads();
        { const int kg = tid & 7, n = tid >> 3;
          float v[8];
#pragma unroll
          for (int i = 0; i < 8; ++i) v[i] = tile[(kg * 8 + i) * 65 + n];
          u32x4 w; w.x = cvt_pk_bf16(v[0], v[1]); w.y = cvt_pk_bf16(v[2], v[3]); w.z = cvt_pk_bf16(v[4], v[5]); w.w = cvt_pk_bf16(v[6], v[7]);
          *(u32x4*)(dst + (size_t)(n0 + n) * K + k0 + kg * 8) = w; }
        __syncthreads();
    }
}

static __device__ __forceinline__ void convert_layer(const Params& p, int l, LAS unsigned char* lds, int wi, int nw, int wv) {
    bf16_t* W = (bf16_t*)(p.ws + WS_W);
    convert_tiles<1>(p.in[I_F1G] + (size_t)l * DM * DFF, p.in[I_F1U] + (size_t)l * DM * DFF, W + W_GU1, DM, DFF, 2 * DFF, lds, wi, nw, wv);
    convert_tiles<0>(p.in[I_F1D] + (size_t)l * DFF * DM, nullptr, W + W_DN1, DFF, DM, DM, lds, wi, nw, wv);
    convert_tiles<2>(p.in[I_WIN] + (size_t)l * DM * DIN, nullptr, W + W_IN, DM, DIN, NPJ, lds, wi, nw, wv);
    convert_tiles<0>(p.in[I_WOUT] + (size_t)l * DMIX * DM, nullptr, W + W_OUT, DMIX, DM, DM, lds, wi, nw, wv);
    convert_tiles<1>(p.in[I_F2G] + (size_t)l * DM * DFF, p.in[I_F2U] + (size_t)l * DM * DFF, W + W_GU2, DM, DFF, 2 * DFF, lds, wi, nw, wv);
    convert_tiles<0>(p.in[I_F2D] + (size_t)l * DFF * DM, nullptr, W + W_DN2, DFF, DM, DM, lds, wi, nw, wv);
    convert_tiles<0>(p.in[I_5GLU] + (size_t)l * WG * WG, nullptr, W + W_GLU, WG, WG, WG, lds, wi, nw, wv);
}

template <bool INIT>
static __device__ __forceinline__ void norm_phase(const Params& p, const float* gain, int wv, int npk) {
    float* H = (float*)(p.ws + WS_H); bf16_t* XN = (bf16_t*)(p.ws + WS_XN);
    const int tid = opaque_tid(wv), lane = tid & 63, gw = opaque_s(blockIdx.x) * 8 + (tid >> 6), nw = gridDim.x * 8;
    f32x4 g[4];
#pragma unroll
    for (int i = 0; i < 4; ++i) g[i] = *(const f32x4*)(gain + 4 * lane + 256 * i);
    f32x4 nxt[4];
    if (!INIT && gw < MP) {
#pragma unroll
        for (int i = 0; i < 4; ++i) nxt[i] = *(const f32x4*)(H + (size_t)gw * DM + 4 * lane + 256 * i);
    }
    for (int r = gw; r < MP; r += nw) {
        f32x4 v[4];
        if (INIT) {
            const int b = r / TP, tp = r % TP;
            const float* src = nullptr;
            if (tp >= LEAD + NMETA) src = p.in[I_X] + ((size_t)b * SEQ + (tp - LEAD - NMETA)) * DM;
            else if (tp >= LEAD) src = p.in[I_META] + (size_t)(tp - LEAD) * DM;
#pragma unroll
            for (int i = 0; i < 4; ++i) { v[i] = src ? *(const f32x4*)(src + 4 * lane + 256 * i) : (f32x4){0.f, 0.f, 0.f, 0.f}; *(f32x4*)(H + (size_t)r * DM + 4 * lane + 256 * i) = v[i]; }
        } else {
#pragma unroll
            for (int i = 0; i < 4; ++i) v[i] = nxt[i];
            if (r + nw < MP) {
#pragma unroll
                for (int i = 0; i < 4; ++i) nxt[i] = *(const f32x4*)(H + (size_t)(r + nw) * DM + 4 * lane + 256 * i);
            }
            if (r >= 64 * 256 && npk > 0) {
                const float* PART = (const float*)(p.ws + WS_PART) + (size_t)(r - 64 * 256) * DM + 4 * lane;
                for (int q = 0; q < npk; ++q)
#pragma unroll
                    for (int i = 0; i < 4; ++i) v[i] = v[i] + *(const f32x4*)(PART + (size_t)q * (512 * DM) + 256 * i);
#pragma unroll
                for (int i = 0; i < 4; ++i) *(f32x4*)(H + (size_t)r * DM + 4 * lane + 256 * i) = v[i];
            }
        }
        float s = 0.f;
#pragma unroll
        for (int i = 0; i < 4; ++i) s += v[i][0] * v[i][0] + v[i][1] * v[i][1] + v[i][2] * v[i][2] + v[i][3] * v[i][3];
#pragma unroll
        for (int o = 32; o >= 1; o >>= 1) s += shx(s, o, lane);
        const float rstd = rsqrtf(s * (1.0f / DM) + 1e-6f);
#pragma unroll
        for (int i = 0; i < 4; ++i) { const f32x4 y = v[i] * rstd * g[i]; u32x2 w; w.x = cvt_pk_bf16(y[0], y[1]); w.y = cvt_pk_bf16(y[2], y[3]);
            *(u32x2*)(XN + (size_t)r * DM + 4 * lane + 256 * i) = w; }
    }
}
static __device__ __forceinline__ void final_phase(const Params& p, int wv) {
    const float* H = (const float*)(p.ws + WS_H); const float* gain = p.in[I_FINN];
    const int tid = opaque_tid(wv), lane = tid & 63, gw = opaque_s(blockIdx.x) * 8 + (tid >> 6), nw = gridDim.x * 8;
    f32x4 g[4];
#pragma unroll
    for (int i = 0; i < 4; ++i) g[i] = *(const f32x4*)(gain + 4 * lane + 256 * i);
    for (int o = gw; o < NB * SEQ; o += nw) {
        const int b = o / SEQ, t = o % SEQ; const size_t r = (size_t)b * TP + LEAD + NMETA + t;
        f32x4 v[4]; float s = 0.f;
#pragma unroll
        for (int i = 0; i < 4; ++i) v[i] = *(const f32x4*)(H + r * DM + 4 * lane + 256 * i);
        if (r >= 64 * 256) { const float* PART = (const float*)(p.ws + WS_PART) + (r - 64 * 256) * DM + 4 * lane;
            for (int q = 0; q < DFF / 256; ++q)
#pragma unroll
                for (int i = 0; i < 4; ++i) v[i] = v[i] + *(const f32x4*)(PART + (size_t)q * (512 * DM) + 256 * i); }
#pragma unroll
        for (int i = 0; i < 4; ++i) s += v[i][0] * v[i][0] + v[i][1] * v[i][1] + v[i][2] * v[i][2] + v[i][3] * v[i][3];
#pragma unroll
        for (int q = 32; q >= 1; q >>= 1) s += shx(s, q, lane);
        const float rstd = rsqrtf(s * (1.0f / DM) + 1e-6f);
#pragma unroll
        for (int i = 0; i < 4; ++i) *(f32x4*)(p.out + (size_t)o * DM + 4 * lane + 256 * i) = v[i] * rstd * g[i];
    }
}

__device__ __forceinline__ f32x4 mfma16(bf16x8 a, bf16x8 b, f32x4 c) { return __builtin_amdgcn_mfma_f32_16x16x32_bf16(a, b, c, 0, 0, 0); }
__device__ __forceinline__ bf16x8 ldsfrag(const LAS bf16_t* M, int ld, int r, int k) { return *(const LAS bf16x8*)(M + r * ld + k); }
template <int K> __device__ __forceinline__ f32x4 mma_n(const LAS bf16_t* A, int lda, int r0, const LAS bf16_t* Bt, int ldb, int c0, int fr, int fq, f32x4 acc) {
#pragma unroll
    for (int k = 0; k < K; k += 32) acc = mfma16(ldsfrag(A, lda, r0 + fr, k + fq * 8), ldsfrag(Bt, ldb, c0 + fr, k + fq * 8), acc);
    return acc;
}
template <int K> __device__ __forceinline__ f32x4 mma_t(const LAS bf16_t* A, int lda, int r0, const LAS bf16_t* Bt, int ldb, int c0, int fr, int fq, f32x4 acc) {
#pragma unroll
    for (int k = 0; k < K; k += 32) acc = mfma16(ldsfrag(Bt, ldb, c0 + fr, k + fq * 8), ldsfrag(A, lda, r0 + fr, k + fq * 8), acc);
    return acc;
}
__device__ __forceinline__ float bflo(unsigned u) { return __uint_as_float(u << 16); }
__device__ __forceinline__ float bfhi(unsigned u) { return __uint_as_float(u & 0xffff0000u); }
__device__ __forceinline__ void unpack8(const u32x4 v, float (&x)[8]) { x[0] = bflo(v.x); x[1] = bfhi(v.x); x[2] = bflo(v.y); x[3] = bfhi(v.y); x[4] = bflo(v.z); x[5] = bfhi(v.z); x[6] = bflo(v.w); x[7] = bfhi(v.w); }
__device__ __forceinline__ u32x4 pack8(const float (&x)[8]) { u32x4 w; w.x = cvt_pk_bf16(x[0], x[1]); w.y = cvt_pk_bf16(x[2], x[3]); w.z = cvt_pk_bf16(x[4], x[5]); w.w = cvt_pk_bf16(x[6], x[7]); return w; }
__device__ __forceinline__ u32x2 pack4(const f32x4 v) { u32x2 w; w.x = cvt_pk_bf16(v[0], v[1]); w.y = cvt_pk_bf16(v[2], v[3]); return w; }
__device__ __forceinline__ void lds_wave_sync() { asm volatile("s_waitcnt lgkmcnt(0)" ::: "memory"); }
__device__ __forceinline__ float wave_incl_scan(float v, int lane) {
#pragma unroll
    for (int o = 1; o < 64; o <<= 1) { const float t = shidx(v, lane - o); if (lane >= o) v += t; }
    return v;
}

static __device__ __forceinline__ void gdn_qk_prepass(const Params& p, int l, int bid, int G, int wv) {
    const bf16_t* PROJ = (const bf16_t*)(p.ws + WS_PROJ); bf16_t* QK = (bf16_t*)(p.ws + WS_XN);
    for (int item = bid; item < NB * 33; item += G) {
        const int b = item / 33, n = item % 33; const size_t brow = (size_t)b * TP; const int tp0 = n * 64;
#pragma unroll 1
        for (int pass = 0; pass < 2; ++pass) {
            const int tid = opaque_tid(wv), lane = tid & 63, co = tid & 127, tg = (tid >> 7) + pass * 4;
            const float* cwp = p.in[I_GCW] + (size_t)l * 4 * 1536 + co * 8;
            float cw[4][8];
#pragma unroll
            for (int j = 0; j < 4; ++j) { const f32x4 a0 = *(const f32x4*)(cwp + j * 1536), a1 = *(const f32x4*)(cwp + j * 1536 + 4);
                cw[j][0] = a0[0]; cw[j][1] = a0[1]; cw[j][2] = a0[2]; cw[j][3] = a0[3]; cw[j][4] = a1[0]; cw[j][5] = a1[1]; cw[j][6] = a1[2]; cw[j][7] = a1[3]; }
            const bf16_t* colbase = PROJ + brow * PJ_LD + 1024 + co * 8;
            u32x4 xr[11];
#pragma unroll
            for (int i = 0; i < 11; ++i) { const int tp = tp0 + tg * 8 - 3 + i; xr[i] = (tp >= 0) ? *(const u32x4*)(colbase + (size_t)tp * PJ_LD) : (u32x4){0u, 0u, 0u, 0u}; }
            const float qs = co < 64 ? 0.08838834764831845f : 1.0f;
#pragma unroll
            for (int t = 0; t < 8; ++t) {
                float o[8];
#pragma unroll
                for (int c = 0; c < 8; ++c) o[c] = 0.f;
#pragma unroll
                for (int j = 0; j < 4; ++j) { float x[8]; unpack8(xr[t + j], x);
#pragma unroll
                    for (int c = 0; c < 8; ++c) o[c] += cw[j][c] * x[c]; }
                float ss = 0.f;
#pragma unroll
                for (int c = 0; c < 8; ++c) { o[c] = siluf_(o[c]); ss += o[c] * o[c]; }
                ss += shx(ss, 1, lane); ss += shx(ss, 2, lane); ss += shx(ss, 4, lane); ss += shx(ss, 8, lane);
                const float rn = rsqrtf(ss + 1e-6f) * qs;
#pragma unroll
                for (int c = 0; c < 8; ++c) o[c] *= rn;
                *(u32x4*)(QK + (brow + tp0 + tg * 8 + t) * DM + co * 8) = pack8(o);
            }
        }
    }
}

static __device__ __forceinline__ void gdn_produce(const Params& p, int l, int le, int bh, int n, LAS unsigned char* lds, int wv) {
    const int tid = opaque_tid(wv), lane = tid & 63, w = __builtin_amdgcn_readfirstlane(tid >> 6), fr = lane & 15, fq = lane >> 4;
    const int b = bh >> 2, h = bh & 3;
    LAS bf16_t* Qs = (LAS bf16_t*)(lds);
    LAS bf16_t* Ks = (LAS bf16_t*)(lds + 17408);
    LAS bf16_t* As = (LAS bf16_t*)(lds + 34816);
    LAS bf16_t* Tm = (LAS bf16_t*)(lds + 44032);
    LAS float* Lm = (LAS float*)(lds + 53248);
    LAS float* gc = (LAS float*)(lds + 70656);
    LAS float* bt = gc + 64;
    const bf16_t* PROJ = (const bf16_t*)(p.ws + WS_PROJ); const float* SM = (const float*)(p.ws + WS_SM);
    const size_t brow = (size_t)b * TP;
    const int tp0 = n * 64;
    if (tid < 256) {
        const int seg = tid >> 7, idx = tid & 127, tg = idx >> 4, oc = idx & 15;
        const float* cwp = p.in[I_GCW] + (size_t)l * 4 * 1536 + seg * 512 + h * 128 + oc * 8;
        const bf16_t* colbase = PROJ + brow * PJ_LD + 1024 + seg * 512 + h * 128 + oc * 8;
        float cw[4][8];
#pragma unroll
        for (int j = 0; j < 4; ++j) { const f32x4 a0 = *(const f32x4*)(cwp + j * 1536), a1 = *(const f32x4*)(cwp + j * 1536 + 4);
            cw[j][0] = a0[0]; cw[j][1] = a0[1]; cw[j][2] = a0[2]; cw[j][3] = a0[3]; cw[j][4] = a1[0]; cw[j][5] = a1[1]; cw[j][6] = a1[2]; cw[j][7] = a1[3]; }
        u32x4 xr[11];
#pragma unroll
        for (int i = 0; i < 11; ++i) { const int tp = tp0 + tg * 8 - 3 + i; xr[i] = (tp >= 0) ? *(const u32x4*)(colbase + (size_t)tp * PJ_LD) : (u32x4){0u, 0u, 0u, 0u}; }
        LAS bf16_t* dst = seg == 0 ? Qs : Ks;
#pragma unroll
        for (int t = 0; t < 8; ++t) {
            float o[8];
#pragma unroll
            for (int c = 0; c < 8; ++c) o[c] = 0.f;
#pragma unroll
            for (int j = 0; j < 4; ++j) { float x[8]; unpack8(xr[t + j], x);
#pragma unroll
                for (int c = 0; c < 8; ++c) o[c] += cw[j][c] * x[c]; }
            float ss = 0.f;
#pragma unroll
            for (int c = 0; c < 8; ++c) { o[c] = siluf_(o[c]); ss += o[c] * o[c]; }
            ss += shx(ss, 1, lane); ss += shx(ss, 2, lane); ss += shx(ss, 4, lane); ss += shx(ss, 8, lane);
            const float rn = rsqrtf(ss + 1e-6f) * (seg == 0 ? 0.08838834764831845f : 1.0f);
#pragma unroll
            for (int c = 0; c < 8; ++c) o[c] *= rn;
            *(LAS u32x4*)(dst + (tg * 8 + t) * 136 + oc * 8) = pack8(o);
        }
    } else if (w == 6) {
        const float alog_e = __expf(p.in[I_GALOG][l * 4 + h]), dtb = p.in[I_GDTB][l * 4 + h];
        const int tp = tp0 + lane; const size_t row = brow + tp;
        float be = 0.f, g = 0.f;
        if (tp >= LEAD) { be = sigmoidf_(SM[row * 16 + h]); g = -alog_e * softplusf_(SM[row * 16 + 4 + h] + dtb); }
        g = wave_incl_scan(g, lane);
        gc[lane] = g; bt[lane] = be;
    }
    __syncthreads();
#pragma unroll 1
    for (int i = 0; i < 4; ++i) {
        const int t = w * 4 + i;
        const int tt = t & 15, ct = tt >> 2, st = tt & 3; const bool isK = t < 16;
        const int c = ct * 16 + fr, s0 = st * 16 + 4 * fq;
        f32x4 v = (f32x4){0.f, 0.f, 0.f, 0.f};
        if (st <= ct) v = mma_t<128>(isK ? Ks : Qs, 136, ct * 16, Ks, 136, st * 16, fr, fq, v);
        const float gcc = gc[c], bc = bt[c];
        f32x4 o;
#pragma unroll
        for (int j = 0; j < 4; ++j) { const int s = s0 + j; const bool keep = isK ? (s < c) : (s <= c); const float d = keep ? gcc - gc[s] : 0.f; const float val = keep ? v[j] * __expf(d) : 0.f; o[j] = isK ? val * bc : val; }
        if (isK) *(LAS f32x4*)(Lm + c * 68 + s0) = o; else *(LAS u32x2*)(As + c * 72 + s0) = pack4(o);
    }
    __syncthreads();
    if (w == 0) {
        float x[64];
        int lo_ = lane; asm volatile("" : "+v"(lo_));
        const float fl = (float)lo_;
        const LAS float* Lz = Lm + opaque_v0();
#pragma unroll
        for (int c = 0; c < 64; ++c) {
            float a = 0.f;
#pragma unroll
            for (int s4 = 0; s4 + 4 <= c; s4 += 4) { const f32x4 lv = *(const LAS f32x4*)(Lz + c * 68 + s4); a += lv[0] * x[s4]; a += lv[1] * x[s4 + 1]; a += lv[2] * x[s4 + 2]; a += lv[3] * x[s4 + 3]; if ((s4 & 12) == 12) asm volatile("" ::: "memory"); }
#pragma unroll
            for (int s = (c & ~3); s < c; ++s) a += Lz[c * 68 + s] * x[s];
            x[c] = fmaxf(0.f, 1.0f - fabsf(fl - (float)c)) - a;
            Tm[c * 72 + lane] = f2bf(x[c]);
            asm volatile("" ::: "memory");
        }
    }
    __syncthreads();
    { unsigned long long* ta = (unsigned long long*)(p.ws + WS_TA) + ((size_t)(bh * 33 + n)) * 2048;
#pragma unroll
      for (int i = 0; i < 4; ++i) { const int e8 = tid + i * NTHREADS, m = e8 >> 10, r = (e8 >> 4) & 63, c4 = (e8 & 15) * 4;
          const unsigned long long v = *(const LAS unsigned long long*)((m == 0 ? Tm : As) + r * 72 + c4);
          __hip_atomic_store(ta + e8, v, __ATOMIC_RELAXED, __HIP_MEMORY_SCOPE_AGENT); } }
    { unsigned long long* qk = (unsigned long long*)((bf16_t*)(p.ws + WS_XN) + (brow + tp0) * DM + h * 128);
#pragma unroll
      for (int i = 0; i < 8; ++i) { const int e8 = tid + i * NTHREADS, m = e8 >> 11, r = (e8 >> 5) & 63, c4 = (e8 & 31) * 4;
          const unsigned long long v = *(const LAS unsigned long long*)((m == 0 ? Qs : Ks) + r * 136 + c4);
          __hip_atomic_store(qk + ((size_t)r * DM + m * 512 + c4) / 4, v, __ATOMIC_RELAXED, __HIP_MEMORY_SCOPE_AGENT); } }
    asm volatile("s_waitcnt vmcnt(0)" ::: "memory");
    __syncthreads();
    if (tid == 0) __hip_atomic_store((unsigned*)(p.ws + WS_FLAG) + bh * 33 + n, (unsigned)(le + 1), __ATOMIC_RELAXED, __HIP_MEMORY_SCOPE_AGENT);
}
static __device__ __forceinline__ void gdn_helper_loop(const Params& p, int l, int le, LAS unsigned char* lds, int wv, int max_items = 1 << 30) {
    LAS unsigned* slot = (LAS unsigned*)(lds + 81920);
    unsigned* qhead = (unsigned*)(p.ws + WS_FLAG) + 1200 + le;
    for (;;) {
        const int tid = opaque_tid(wv);
        __syncthreads();
        if (tid == 0) slot[0] = __hip_atomic_fetch_add(qhead, 1u, __ATOMIC_RELAXED, __HIP_MEMORY_SCOPE_AGENT);
        __syncthreads();
        const unsigned item = slot[0];
        if (item >= 32u * 33u) break;
        gdn_produce(p, l, le, (int)(item & 31u), (int)(item >> 5), lds, wv);
        if (--max_items <= 0) { __syncthreads(); break; }
    }
}
static __device__ __forceinline__ void gdn_mixer(const Params& p, int l, int le, int b, int h, LAS unsigned char* lds, int wv) {
    LAS bf16_t* Qs = (LAS bf16_t*)(lds);
    LAS bf16_t* Ks = (LAS bf16_t*)(lds + 17408);
    LAS bf16_t* Vs = (LAS bf16_t*)(lds + 34816);
    LAS bf16_t* VT = Vs;
    LAS bf16_t* St = (LAS bf16_t*)(lds + 53248);
    LAS bf16_t* RT = (LAS bf16_t*)(lds + 88064);
    LAS bf16_t* As = (LAS bf16_t*)(lds + 106496);
    LAS bf16_t* Tm = (LAS bf16_t*)(lds + 115712);
    LAS float* Lm = (LAS float*)(lds + 124928);
    LAS bf16_t* KdT = (LAS bf16_t*)(lds + 124928);
    LAS float* gc = (LAS float*)(lds + 143360);
    LAS float* bt = gc + 64;
    LAS float* ssum = gc + 128;
    const bf16_t* PROJ = (const bf16_t*)(p.ws + WS_PROJ); const float* SM = (const float*)(p.ws + WS_SM); bf16_t* Y = (bf16_t*)(p.ws + WS_Y);
    const size_t brow = (size_t)b * TP;
    const float alog_e = __expf(p.in[I_GALOG][l * 4 + h]), dtb = p.in[I_GDTB][l * 4 + h];
    for (int i = opaque_tid(wv); i < 34816 / 4; i += NTHREADS) ((LAS unsigned*)St)[i] = 0u;
    f32x4 sacc[8];
#pragma unroll
    for (int i = 0; i < 8; ++i) sacc[i] = (f32x4){0.f, 0.f, 0.f, 0.f};
    __syncthreads();
    if (__builtin_amdgcn_readfirstlane(opaque_tid(wv) >> 6) == 1) { const unsigned* fl = (const unsigned*)(p.ws + WS_FLAG) + (b * 4 + h) * 33 + 0;
              unsigned spins = 0;
              while ((unsigned)__builtin_amdgcn_readfirstlane((int)__hip_atomic_load(fl, __ATOMIC_RELAXED, __HIP_MEMORY_SCOPE_AGENT)) != (unsigned)(le + 1)) { __builtin_amdgcn_s_sleep(2); if (++spins > (1u << 22)) break; }
              __builtin_amdgcn_fence(__ATOMIC_ACQUIRE, "agent");
              asm volatile("s_waitcnt vmcnt(0)" ::: "memory"); }
    __syncthreads();
    for (int n = 0; n < 33; ++n) {
        const int tp0 = n * 64;
        const int tid = opaque_tid(wv), lane = tid & 63, w = __builtin_amdgcn_readfirstlane(tid >> 6), fr = lane & 15, fq = lane >> 4;
        const int seg = tid >> 7, idx = tid & 127, tg = idx >> 4, oc = idx & 15, ct5 = w & 3, eh = w >> 2;
        const float* cwp0 = p.in[I_GCW] + (size_t)l * 4 * 1536 + (tid < 384 ? seg * 512 + h * 128 + oc * 8 : 0);
        if (tid < 256) {
            const bf16_t* QK = (const bf16_t*)(p.ws + WS_XN) + (brow + tp0) * DM + h * 128;
#pragma unroll
            for (int i = 0; i < 8; ++i) { const int e16 = tid + i * 256, m = e16 >> 10, r = (e16 >> 4) & 63, c8 = (e16 & 15) * 8;
                *(LAS u32x4*)((m == 0 ? Qs : Ks) + r * 136 + c8) = *(const u32x4*)(QK + (size_t)r * DM + m * 512 + c8); }
            if (w == 0) {
                const int tp = tp0 + lane; const size_t row = brow + tp;
                float be = 0.f, g = 0.f;
                if (tp >= LEAD) { be = sigmoidf_(SM[row * 16 + h]); g = -alog_e * softplusf_(SM[row * 16 + 4 + h] + dtb); }
                g = wave_incl_scan(g, lane);
                gc[lane] = g; bt[lane] = be;
            }
        } else {
            const int i2 = tid - 256, oc2 = i2 & 15, tg4 = i2 >> 4;
            const float* cwp = p.in[I_GCW] + (size_t)l * 4 * 1536 + 1024 + h * 128 + oc2 * 8; asm volatile("" : "+v"(cwp));
            float cw[4][8];
#pragma unroll
            for (int j = 0; j < 4; ++j) { const f32x4 a0 = *(const f32x4*)(cwp + j * 1536), a1 = *(const f32x4*)(cwp + j * 1536 + 4);
                cw[j][0] = a0[0]; cw[j][1] = a0[1]; cw[j][2] = a0[2]; cw[j][3] = a0[3]; cw[j][4] = a1[0]; cw[j][5] = a1[1]; cw[j][6] = a1[2]; cw[j][7] = a1[3]; }
            const bf16_t* colbase = PROJ + brow * PJ_LD + 2048 + h * 128 + oc2 * 8;
            u32x4 xr[7];
#pragma unroll
            for (int i = 0; i < 7; ++i) { const int tp = tp0 + tg4 * 4 - 3 + i; xr[i] = (tp >= 0) ? *(const u32x4*)(colbase + (size_t)tp * PJ_LD) : (u32x4){0u, 0u, 0u, 0u}; }
#pragma unroll
            for (int t = 0; t < 4; ++t) {
                float o[8];
#pragma unroll
                for (int c = 0; c < 8; ++c) o[c] = 0.f;
#pragma unroll
                for (int j = 0; j < 4; ++j) { float x[8]; unpack8(xr[t + j], x);
#pragma unroll
                    for (int c = 0; c < 8; ++c) o[c] += cw[j][c] * x[c]; }
#pragma unroll
                for (int c = 0; c < 8; ++c) o[c] = siluf_(o[c]);
                *(LAS u32x4*)(Vs + (tg4 * 4 + t) * 136 + oc2 * 8) = pack8(o);
            }
        }
        __syncthreads();
        const float gcl = gc[63];
        { const unsigned long long* ta = (const unsigned long long*)(p.ws + WS_TA) + ((size_t)((b * 4 + h) * 33 + n)) * 2048;
#pragma unroll
          for (int i = 0; i < 4; ++i) { const int e8 = tid + i * NTHREADS, m = e8 >> 10, r = (e8 >> 4) & 63, c4 = (e8 & 15) * 4;
              const unsigned long long v = ta[e8];
              *(LAS unsigned long long*)((m == 0 ? Tm : As) + r * 72 + c4) = v; } }
#pragma unroll 1
        for (int i = 0; i < 4; ++i) {
            const int tt = w * 4 + i, ct = tt >> 3, et = tt & 7;
            f32x4 v = mma_n<128>(Ks, 136, ct * 16, St, 136, et * 16, fr, fq, (f32x4){0.f, 0.f, 0.f, 0.f});
            const int e = et * 16 + fr, c0 = ct * 16 + 4 * fq;
            f32x4 r;
#pragma unroll
            for (int j = 0; j < 4; ++j) { const int c = c0 + j; r[j] = bt[c] * (bf2f(Vs[c * 136 + e]) - __expf(gc[c]) * v[j]); }
            *(LAS u32x2*)(RT + e * 72 + c0) = pack4(r);
        }
        __syncthreads();
#pragma unroll 1
        for (int i = 0; i < 4; ++i) { const int t = w * 4 + i, ct = t >> 3, et = t & 7;
            const f32x4 v = mma_n<64>(Tm, 72, ct * 16, RT, 72, et * 16, fr, fq, (f32x4){0.f, 0.f, 0.f, 0.f});
            *(LAS u32x2*)(VT + (et * 16 + fr) * 72 + ct * 16 + 4 * fq) = pack4(v); }
        { const int d = tid & 127, cg4 = tid >> 7;
#pragma unroll
            for (int i = 0; i < 16; ++i) { const int c = cg4 * 16 + i; KdT[d * 72 + c] = f2bf(bf2f(Ks[c * 136 + d]) * __expf(gcl - gc[c])); } }
        __syncthreads();
        if (w == 1 && n + 1 < 33) { const unsigned* fl = (const unsigned*)(p.ws + WS_FLAG) + (b * 4 + h) * 33 + (n + 1);
              unsigned spins = 0;
              while ((unsigned)__builtin_amdgcn_readfirstlane((int)__hip_atomic_load(fl, __ATOMIC_RELAXED, __HIP_MEMORY_SCOPE_AGENT)) != (unsigned)(le + 1)) { __builtin_amdgcn_s_sleep(2); if (++spins > (1u << 22)) break; }
              __builtin_amdgcn_fence(__ATOMIC_ACQUIRE, "agent");
              asm volatile("s_waitcnt vmcnt(0)" ::: "memory"); }
        const int c5 = ct5 * 16 + fr; const float egc = __expf(gc[c5]);
        f32x4 o[4]; float ssq = 0.f;
#pragma unroll
        for (int i = 0; i < 4; ++i) { const int et = eh * 4 + i;
            f32x4 v = mma_t<128>(Qs, 136, ct5 * 16, St, 136, et * 16, fr, fq, (f32x4){0.f, 0.f, 0.f, 0.f});
            v = v * egc;
            v = mma_t<64>(As, 72, ct5 * 16, VT, 72, et * 16, fr, fq, v);
            o[i] = v; ssq += v[0] * v[0] + v[1] * v[1] + v[2] * v[2] + v[3] * v[3]; }
        ssq += shx(ssq, 16, lane); ssq += shx(ssq, 32, lane);
        if (fq == 0) ssum[eh * 64 + c5] = ssq;
        const float last = __expf(gcl);
#pragma unroll
        for (int dt = 0; dt < 8; ++dt) { sacc[dt] = sacc[dt] * last; sacc[dt] = mma_t<64>(VT, 72, w * 16, KdT, 72, dt * 16, fr, fq, sacc[dt]); }
        __syncthreads();
        { const float tot = ssum[c5] + ssum[64 + c5]; const float rstd = rsqrtf(tot * (1.0f / 128.0f) + 1e-6f);
          const size_t row = brow + tp0 + c5;
#pragma unroll
          for (int i = 0; i < 4; ++i) { const int e0 = (eh * 4 + i) * 16 + 4 * fq;
              const u32x2 zz = *(const u32x2*)(PROJ + row * PJ_LD + 2560 + h * 128 + e0);
              const f32x4 g4 = *(const f32x4*)(p.in[I_GNORM] + l * 128 + e0);
              f32x4 y; y[0] = o[i][0] * rstd * g4[0] * siluf_(bflo(zz.x)); y[1] = o[i][1] * rstd * g4[1] * siluf_(bfhi(zz.x));
              y[2] = o[i][2] * rstd * g4[2] * siluf_(bflo(zz.y)); y[3] = o[i][3] * rstd * g4[3] * siluf_(bfhi(zz.y));
              *(u32x2*)(Y + row * DMIX + 512 + h * 128 + e0) = pack4(ymask_on(0) ? y : (f32x4){0.f, 0.f, 0.f, 0.f}); } }
#pragma unroll
        for (int dt = 0; dt < 8; ++dt) *(LAS u32x2*)(St + (w * 16 + fr) * 136 + dt * 16 + 4 * fq) = pack4(sacc[dt]);
    }
}

static __device__ __forceinline__ void ssd_mixer(const Params& p, int l, int b, int gi, int eh, LAS unsigned char* lds, int wv) {
    const int tid0 = opaque_tid(wv);
    LAS bf16_t* Cs = (LAS bf16_t*)(lds);
    LAS bf16_t* Bs = (LAS bf16_t*)(lds + 17408);
    LAS bf16_t* BsT = (LAS bf16_t*)(lds + 34816);
    LAS bf16_t* Xs = (LAS bf16_t*)(lds + 53248);
    LAS float* CBf = (LAS float*)(lds + 87040);
    LAS bf16_t* Ms = (LAS bf16_t*)(lds + 104448);
    LAS bf16_t* XsT = (LAS bf16_t*)(lds + 113664);
    LAS bf16_t* XdT = (LAS bf16_t*)(lds + 122880);
    LAS bf16_t* Sb = (LAS bf16_t*)(lds + 132096);
    LAS float* dtl = (LAS float*)(lds + 149504);
    LAS float* acm = dtl + 256;
    const bf16_t* PROJ = (const bf16_t*)(p.ws + WS_PROJ); const float* SM = (const float*)(p.ws + WS_SM); bf16_t* Y = (bf16_t*)(p.ws + WS_Y);
    const size_t brow = (size_t)b * TP;
    const int w0 = __builtin_amdgcn_readfirstlane(tid0 >> 6);
    const float nalog = -__expf(p.in[I_SALOG][l * 8 + gi * 4 + (w0 & 3)]), dtb = p.in[I_SDTB][l * 8 + gi * 4 + (w0 & 3)];
    f32x4 sacc[4];
#pragma unroll
    for (int i = 0; i < 4; ++i) sacc[i] = (f32x4){0.f, 0.f, 0.f, 0.f};
    for (int n = 0; n < 33; ++n) {
        const int tp0 = n * 64;
        const int tid = opaque_tid(wv);
        const int lane = tid & 63, w = __builtin_amdgcn_readfirstlane(tid >> 6), fr = lane & 15, fq = lane >> 4;
        const int oc = lane, tg = w;
        const int xi = oc < 32 ? gi * 256 + oc * 8 : (oc < 48 ? 512 + gi * 128 + (oc - 32) * 8 : 768 + gi * 128 + (oc - 48) * 8);
        const int hh_w = gi * 4 + (w & 3);
        const int lt = w & 3, ph = w >> 2;
        const float* cwp0 = p.in[I_SCW] + (size_t)l * 4 * 1024 + xi; const float* cbp0 = p.in[I_SCB] + (size_t)l * 1024 + xi;
        {
            const bf16_t* colbase = PROJ + brow * PJ_LD + 3584 + xi;
            float cw[4][8], cb[8];
            { const float* cwp = cwp0; const float* cbp = cbp0; asm volatile("" : "+v"(cwp), "+v"(cbp));
              { const f32x4 a0 = *(const f32x4*)(cbp), a1 = *(const f32x4*)(cbp + 4); cb[0] = a0[0]; cb[1] = a0[1]; cb[2] = a0[2]; cb[3] = a0[3]; cb[4] = a1[0]; cb[5] = a1[1]; cb[6] = a1[2]; cb[7] = a1[3]; }
#pragma unroll
              for (int j = 0; j < 4; ++j) { const f32x4 a0 = *(const f32x4*)(cwp + j * 1024), a1 = *(const f32x4*)(cwp + j * 1024 + 4);
                  cw[j][0] = a0[0]; cw[j][1] = a0[1]; cw[j][2] = a0[2]; cw[j][3] = a0[3]; cw[j][4] = a1[0]; cw[j][5] = a1[1]; cw[j][6] = a1[2]; cw[j][7] = a1[3]; } }
            u32x4 xr[11];
#pragma unroll
            for (int i = 0; i < 11; ++i) { const int tp = tp0 + tg * 8 - 3 + i; xr[i] = (tp >= 0) ? *(const u32x4*)(colbase + (size_t)tp * PJ_LD) : (u32x4){0u, 0u, 0u, 0u}; }
#pragma unroll
            for (int t = 0; t < 8; ++t) {
                const int tt = tg * 8 + t; const bool valid = (tp0 + tt) >= LEAD;
                float o[8];
#pragma unroll
                for (int c = 0; c < 8; ++c) o[c] = cb[c];
#pragma unroll
                for (int j = 0; j < 4; ++j) { float x[8]; unpack8(xr[t + j], x);
#pragma unroll
                    for (int c = 0; c < 8; ++c) o[c] += cw[j][c] * x[c]; }
#pragma unroll
                for (int c = 0; c < 8; ++c) o[c] = valid ? siluf_(o[c]) : 0.f;
                const u32x4 pk = pack8(o);
                if (oc < 32) *(LAS u32x4*)(Xs + tt * 264 + oc * 8) = pk;
                else if (oc < 48) { *(LAS u32x4*)(Bs + tt * 136 + (oc - 32) * 8) = pk;
#pragma unroll
                    for (int c = 0; c < 8; ++c) BsT[((oc - 32) * 8 + c) * 72 + tt] = f2bf(o[c]); }
                else *(LAS u32x4*)(Cs + tt * 136 + (oc - 48) * 8) = pk;
            }
            if (w < 4) {
                const int tp = tp0 + lane; const size_t row = brow + tp;
                float dt = 0.f;
                if (tp >= LEAD) dt = softplusf_(SM[row * 16 + 8 + hh_w] + dtb);
                const float a = wave_incl_scan(nalog * dt, lane);
                dtl[w * 64 + lane] = dt; acm[w * 64 + lane] = a;
            }
        }
        __syncthreads();
#pragma unroll 1
        for (int i = 0; i < 2; ++i) { const int t = w * 2 + i, ltt = t >> 2, st = t & 3;
            f32x4 v = (f32x4){0.f, 0.f, 0.f, 0.f};
            if (st <= ltt) v = mma_t<128>(Cs, 136, ltt * 16, Bs, 136, st * 16, fr, fq, v);
            *(LAS f32x4*)(CBf + (ltt * 16 + fr) * 68 + st * 16 + 4 * fq) = v; }
        __syncthreads();
        f32x4 yv[2];
        { const int e = eh;
            const float alast = acm[e * 64 + 63];
#pragma unroll
            for (int i = 0; i < 4; ++i) { const f32x4 sv = sacc[i];
                *(LAS u32x2*)(Sb + (lt * 16 + fr) * 136 + (ph * 4 + i) * 16 + 4 * fq) = pack4(sv); }
            { const int ll = tid >> 3, s0 = (tid & 7) * 8; const float al = acm[e * 64 + ll];
              float m[8];
#pragma unroll
              for (int j = 0; j < 8; ++j) { const int s = s0 + j; const bool keep = s <= ll; const float d = keep ? al - acm[e * 64 + s] : 0.f; m[j] = keep ? CBf[ll * 68 + s] * __expf(d) * dtl[e * 64 + s] : 0.f; }
              *(LAS u32x4*)(Ms + ll * 72 + s0) = pack8(m); }
            { const int pp = tid & 63, lg = tid >> 6;
              float xs8[8], xd8[8];
#pragma unroll
              for (int i = 0; i < 8; ++i) { const int ll = lg * 8 + i; const float x = bf2f(Xs[ll * 264 + e * 64 + pp]); xs8[i] = x; xd8[i] = x * __expf(alast - acm[e * 64 + ll]) * dtl[e * 64 + ll]; }
              *(LAS u32x4*)(XsT + pp * 72 + lg * 8) = pack8(xs8); *(LAS u32x4*)(XdT + pp * 72 + lg * 8) = pack8(xd8); }
            __syncthreads();
            const float eal = __expf(acm[e * 64 + lt * 16 + fr]);
            const float dsk = p.in[I_SD][l * 8 + gi * 4 + e];
#pragma unroll
            for (int i = 0; i < 2; ++i) { const int pt = ph * 2 + i;
                f32x4 v = mma_t<128>(Cs, 136, lt * 16, Sb, 136, pt * 16, fr, fq, (f32x4){0.f, 0.f, 0.f, 0.f});
                v = v * eal;
                v = mma_t<64>(Ms, 72, lt * 16, XsT, 72, pt * 16, fr, fq, v);
                const u32x2 xx = *(const LAS u32x2*)(Xs + (lt * 16 + fr) * 264 + e * 64 + pt * 16 + 4 * fq);
                v[0] += dsk * bflo(xx.x); v[1] += dsk * bfhi(xx.x); v[2] += dsk * bflo(xx.y); v[3] += dsk * bfhi(xx.y);
                yv[i] = v; }
            const float dec = __expf(alast);
#pragma unroll
            for (int i = 0; i < 4; ++i) {
                f32x4 sv = sacc[i] * dec;
                sv = mma_t<64>(XdT, 72, lt * 16, BsT, 72, (ph * 4 + i) * 16, fr, fq, sv);
                sacc[i] = sv; }
            __syncthreads();
        }
        const size_t row = brow + tp0 + lt * 16 + fr;
        float ssq = 0.f;
#pragma unroll
        for (int i = 0; i < 2; ++i) { const int ch = eh * 64 + (ph * 2 + i) * 16 + 4 * fq;
            const u32x2 zz = *(const u32x2*)(PROJ + row * PJ_LD + 3072 + gi * 256 + ch);
            f32x4 v = yv[i];
            v[0] *= siluf_(bflo(zz.x)); v[1] *= siluf_(bfhi(zz.x)); v[2] *= siluf_(bflo(zz.y)); v[3] *= siluf_(bfhi(zz.y));
            ssq += v[0] * v[0] + v[1] * v[1] + v[2] * v[2] + v[3] * v[3];
            *(u32x2*)(Y + row * DMIX + 1024 + gi * 256 + ch) = pack4(v); }
        ssq += shx(ssq, 16, lane); ssq += shx(ssq, 32, lane);
        if (fq == 0) ((float*)(p.ws + WS_SSQ))[row * 16 + gi * 8 + eh * 2 + ph] = ssq;
    }
}

static __device__ __forceinline__ void lru_mixer(const Params& p, int l, int b, int sg, LAS unsigned char* lds, int wv) {
    const int tid = opaque_tid(wv), lane = tid & 63, w = __builtin_amdgcn_readfirstlane(tid >> 6), fr = lane & 15, fq = lane >> 4;
    LAS float* xcs = (LAS float*)(lds + w * 17408);
    LAS float* gts = xcs + 32 * 68;
    bf16_t* PROJ = (bf16_t*)(p.ws + WS_PROJ); bf16_t* Y = (bf16_t*)(p.ws + WS_Y);
    const size_t brow = (size_t)b * TP;
    bf16x8 wa[4][2], wi[4][2];
    { const float* wap = p.in[I_LWA] + (size_t)(l * 8 + w) * 4096; const float* wip = p.in[I_LWI] + (size_t)(l * 8 + w) * 4096;
#pragma unroll
      for (int nt = 0; nt < 4; ++nt)
#pragma unroll
          for (int ks = 0; ks < 2; ++ks) { float a8[8], i8[8];
#pragma unroll
              for (int jj = 0; jj < 8; ++jj) { const int i = ks * 32 + fq * 8 + jj, j = nt * 16 + fr; a8[jj] = wap[i * 64 + j]; i8[jj] = wip[i * 64 + j]; }
              const u32x4 pa = pack8(a8), pi = pack8(i8); wa[nt][ks] = *(const bf16x8*)&pa; wi[nt][ks] = *(const bf16x8*)&pi; } }
    float ba[4], bi[4], sp8[4];
#pragma unroll
    for (int nt = 0; nt < 4; ++nt) { const int ch = l * 512 + w * 64 + nt * 16 + fr; ba[nt] = p.in[I_LBA][ch]; bi[nt] = p.in[I_LBI][ch]; sp8[nt] = 8.0f * softplusf_(-p.in[I_LLAM][ch]); }
    float hc[4] = {0.f, 0.f, 0.f, 0.f}, pc[4] = {1.f, 1.f, 1.f, 1.f};
    for (int hk = sg * LRU_HK; hk < (sg + 1) * LRU_HK; ++hk) {
        const int tp0 = hk * 32;
        const int tidv = opaque_tid(wv);
        const int lane = tidv & 63, fr = lane & 15, fq = lane >> 4, oc = lane & 7, tgp = lane >> 3;
        const float* cwp0 = p.in[I_LCW] + (size_t)l * 4 * 512 + w * 64 + oc * 8; const float* cbp0 = p.in[I_LCB] + (size_t)l * 512 + w * 64 + oc * 8;
        {
            const bf16_t* colx = PROJ + brow * PJ_LD + w * 64 + oc * 8;
            float cw[4][8], cb[8];
            { const float* cwp = cwp0; const float* cbp = cbp0; asm volatile("" : "+v"(cwp), "+v"(cbp));
              { const f32x4 a0 = *(const f32x4*)(cbp), a1 = *(const f32x4*)(cbp + 4); cb[0] = a0[0]; cb[1] = a0[1]; cb[2] = a0[2]; cb[3] = a0[3]; cb[4] = a1[0]; cb[5] = a1[1]; cb[6] = a1[2]; cb[7] = a1[3]; }
#pragma unroll
              for (int j = 0; j < 4; ++j) { const f32x4 a0 = *(const f32x4*)(cwp + j * 512), a1 = *(const f32x4*)(cwp + j * 512 + 4);
                  cw[j][0] = a0[0]; cw[j][1] = a0[1]; cw[j][2] = a0[2]; cw[j][3] = a0[3]; cw[j][4] = a1[0]; cw[j][5] = a1[1]; cw[j][6] = a1[2]; cw[j][7] = a1[3]; } }
            u32x4 xr[7];
#pragma unroll
            for (int i = 0; i < 7; ++i) { const int tp = tp0 + tgp * 4 - 3 + i; xr[i] = (tp >= 0) ? *(const u32x4*)(colx + (size_t)tp * PJ_LD) : (u32x4){0u, 0u, 0u, 0u}; }
#pragma unroll
            for (int t = 0; t < 4; ++t) {
                const int tt = tgp * 4 + t;
                float o[8];
#pragma unroll
                for (int c = 0; c < 8; ++c) o[c] = cb[c];
#pragma unroll
                for (int j = 0; j < 4; ++j) { float x[8]; unpack8(xr[t + j], x);
#pragma unroll
                    for (int c = 0; c < 8; ++c) o[c] += cw[j][c] * x[c]; }
                *(LAS f32x4*)(xcs + tt * 68 + oc * 8) = (f32x4){o[0], o[1], o[2], o[3]}; *(LAS f32x4*)(xcs + tt * 68 + oc * 8 + 4) = (f32x4){o[4], o[5], o[6], o[7]};
                const u32x4 gr = *(const u32x4*)(colx + 512 + (size_t)(tp0 + tt) * PJ_LD);
                float gg[8]; unpack8(gr, gg);
#pragma unroll
                for (int c = 0; c < 8; ++c) gg[c] = gelu_tanh(gg[c]);
                *(LAS f32x4*)(gts + tt * 68 + oc * 8) = (f32x4){gg[0], gg[1], gg[2], gg[3]}; *(LAS f32x4*)(gts + tt * 68 + oc * 8 + 4) = (f32x4){gg[4], gg[5], gg[6], gg[7]};
                __builtin_amdgcn_sched_barrier(0);
            }
        }
        lds_wave_sync();
#pragma unroll
        for (int q = 0; q < 2; ++q) {
            bf16x8 afr[2];
#pragma unroll
            for (int ks = 0; ks < 2; ++ks) { const f32x4 x0 = *(const LAS f32x4*)(xcs + (q * 16 + fr) * 68 + ks * 32 + fq * 8), x1 = *(const LAS f32x4*)(xcs + (q * 16 + fr) * 68 + ks * 32 + fq * 8 + 4);
                u32x4 pk; pk.x = cvt_pk_bf16(x0[0], x0[1]); pk.y = cvt_pk_bf16(x0[2], x0[3]); pk.z = cvt_pk_bf16(x1[0], x1[1]); pk.w = cvt_pk_bf16(x1[2], x1[3]); afr[ks] = *(const bf16x8*)&pk; }
#pragma unroll
            for (int nt = 0; nt < 4; ++nt) {
                f32x4 ar = (f32x4){0.f, 0.f, 0.f, 0.f}, ai = (f32x4){0.f, 0.f, 0.f, 0.f};
                ar = mfma16(afr[0], wa[nt][0], ar); ar = mfma16(afr[1], wa[nt][1], ar);
                ai = mfma16(afr[0], wi[nt][0], ai); ai = mfma16(afr[1], wi[nt][1], ai);
                float a[4], bb[4];
#pragma unroll
                for (int j = 0; j < 4; ++j) { const int tok = q * 16 + 4 * fq + j; const bool valid = (tp0 + tok) >= LEAD;
                    const float r = sigmoidf_(ar[j] + ba[nt]), ig = sigmoidf_(ai[j] + bi[nt]); const float la = -sp8[nt] * r;
                    const float xc = xcs[tok * 68 + nt * 16 + fr];
                    a[j] = valid ? __expf(la) : 1.0f; bb[j] = valid ? sqrtf(neg_expm1(2.0f * la)) * ig * xc : 0.f; }
                const float A4 = a[0] * a[1] * a[2] * a[3], B4 = ((bb[0] * a[1] + bb[1]) * a[2] + bb[2]) * a[3] + bb[3];
                float hprev = hc[nt], hin = hc[nt], pprev = pc[nt], pin = pc[nt];
#pragma unroll
                for (int qq = 0; qq < 4; ++qq) { const float Aq = shidx(A4, fr + 16 * qq), Bq = shidx(B4, fr + 16 * qq); const float hn = Aq * hprev + Bq, pn = Aq * pprev; if (qq + 1 == fq) { hin = hn; pin = pn; } hprev = hn; pprev = pn; }
                hc[nt] = hprev; pc[nt] = pprev;
                float hcur = hin, pcur = pin;
#pragma unroll
                for (int j = 0; j < 4; ++j) { const int tok = q * 16 + 4 * fq + j; hcur = a[j] * hcur + bb[j]; pcur = a[j] * pcur; const float gt = gts[tok * 68 + nt * 16 + fr];
                    const size_t row = brow + tp0 + tok;
                    Y[row * DMIX + w * 64 + nt * 16 + fr] = f2bf(gt * hcur);
                    PROJ[row * PJ_LD + 512 + w * 64 + nt * 16 + fr] = f2bf(gt * pcur); }
                __builtin_amdgcn_sched_barrier(0);
            }
        }
    }
    { float* CAR = (float*)(p.ws + WS_CAR) + ((size_t)(b * LRU_SEG + sg) * 2) * WG + w * 64;
      if (fq == 0) {
#pragma unroll
          for (int nt = 0; nt < 4; ++nt) { CAR[nt * 16 + fr] = hc[nt]; CAR[WG + nt * 16 + fr] = pc[nt]; } } }
}

static __device__ __forceinline__ void lru_fix_tile(const Params& p, int l, LAS unsigned char* lds, int tile, int wv) {
    const int tid = opaque_tid(wv), lane = tid & 63, w = __builtin_amdgcn_readfirstlane(tid >> 6);
    const int b = tile / 33, t = tile % 33, sg = t / 3;
    LAS float* hin = (LAS float*)(lds + 69632);
    const float* CAR = (const float*)(p.ws + WS_CAR) + (size_t)(b * LRU_SEG) * 2 * WG;
    { float ce[LRU_SEG - 1], cp[LRU_SEG - 1];
#pragma unroll
      for (int s = 0; s < LRU_SEG - 1; ++s) { const bool on = s < sg; ce[s] = on ? CAR[(size_t)s * 2 * WG + tid] : 0.f; cp[s] = on ? CAR[(size_t)s * 2 * WG + WG + tid] : 1.f; }
      float h = 0.f;
#pragma unroll
      for (int s = 0; s < LRU_SEG - 1; ++s) h = (s < sg) ? cp[s] * h + ce[s] : h;
      hin[tid] = h; }
    __syncthreads();
    bf16_t* Y = (bf16_t*)(p.ws + WS_Y); const bf16_t* PROJ = (const bf16_t*)(p.ws + WS_PROJ);
    float hv[8], gv[8];
#pragma unroll
    for (int c = 0; c < 8; ++c) { hv[c] = hin[lane * 8 + c]; gv[c] = p.in[I_LNORM][l * 512 + lane * 8 + c]; }
#pragma unroll 1
    for (int i0 = 0; i0 < 8; i0 += 4) {
        u32x4 a1[4], a2[4];
#pragma unroll
        for (int k = 0; k < 4; ++k) { const size_t row = (size_t)tile * 64 + w + 8 * (i0 + k); a1[k] = *(const u32x4*)(Y + row * DMIX + lane * 8); a2[k] = *(const u32x4*)(PROJ + row * PJ_LD + 512 + lane * 8); }
#pragma unroll
        for (int k = 0; k < 4; ++k) { const size_t row = (size_t)tile * 64 + w + 8 * (i0 + k);
            float y1[8], y2[8]; unpack8(a1[k], y1); unpack8(a2[k], y2);
            float ss = 0.f;
#pragma unroll
            for (int c = 0; c < 8; ++c) { y1[c] += y2[c] * hv[c]; ss += y1[c] * y1[c]; }
#pragma unroll
            for (int o = 32; o >= 1; o >>= 1) ss += shx(ss, o, lane);
            const float rstd = rsqrtf(ss * (1.0f / 512.0f) + 1e-6f);
#pragma unroll
            for (int c = 0; c < 8; ++c) y1[c] *= rstd * gv[c];
            *(u32x4*)(Y + row * DMIX + lane * 8) = pack8(y1); }
    }
    __syncthreads();
}
static __device__ __forceinline__ void ssd_norm_tile(const Params& p, int l, int tile, int wv) {
    const int tid = opaque_tid(wv), lane = tid & 63, w = __builtin_amdgcn_readfirstlane(tid >> 6);
    bf16_t* Y = (bf16_t*)(p.ws + WS_Y);
    float sgv[8];
#pragma unroll
    for (int c = 0; c < 8; ++c) sgv[c] = p.in[I_SNORM][l * 512 + lane * 8 + c];
#pragma unroll 1
    for (int i0 = 0; i0 < 8; i0 += 4) {
        u32x4 yy[4]; f32x4 q0[4], q1[4];
#pragma unroll
        for (int k = 0; k < 4; ++k) { const size_t row = (size_t)tile * 64 + w + 8 * (i0 + k); const float* sq = (const float*)(p.ws + WS_SSQ) + row * 16 + (lane >> 5) * 8;
            yy[k] = *(const u32x4*)(Y + row * DMIX + 1024 + lane * 8); q0[k] = *(const f32x4*)sq; q1[k] = *(const f32x4*)(sq + 4); }
#pragma unroll
        for (int k = 0; k < 4; ++k) { const size_t row = (size_t)tile * 64 + w + 8 * (i0 + k);
            const float rs = rsqrtf(((q0[k][0] + q0[k][1]) + (q0[k][2] + q0[k][3]) + (q1[k][0] + q1[k][1]) + (q1[k][2] + q1[k][3])) * (1.0f / 256.0f) + 1e-6f);
            float yc[8]; unpack8(yy[k], yc);
#pragma unroll
            for (int c = 0; c < 8; ++c) yc[c] *= rs * sgv[c];
            *(u32x4*)(Y + row * DMIX + 1024 + lane * 8) = pack8(yc); }
    }
}

static __device__ __forceinline__ void s5_scan(const Params& p, int l, int b, int qd, LAS unsigned char* lds, int wv) {
    const int tid = opaque_tid(wv), lane = tid & 63, w = __builtin_amdgcn_readfirstlane(tid >> 6), fr = lane & 15, fq = lane >> 4;
    const int g = qd * 8 + w, lg = l * 32 + g;
    LAS float* bu = (LAS float*)(lds + w * 12800);
    LAS bf16_t* sb = (LAS bf16_t*)(lds + w * 12800 + 8448);
    const bf16_t* PROJ = (const bf16_t*)(p.ws + WS_PROJ); bf16_t* YP = (bf16_t*)(p.ws + WS_YP);
    const size_t brow = (size_t)b * TP;
    const float dt = __expf(p.in[I_5LDT][lg]);
    float ab_re, ab_im;
    { const float lre = fminf(p.in[I_5ARE][lg * 64 + lane], -1e-4f), lim = p.in[I_5AIM][lg * 64 + lane]; const float mag = expf(dt * lre); ab_re = mag * cosf(dt * lim); ab_im = mag * sinf(dt * lim); }
    bf16x8 bbfr[8];
#pragma unroll
    for (int pt = 0; pt < 8; ++pt) { const int pp = pt * 16 + fr, ps = pp & 63; const bool isim = pp >= 64;
        const float lre = fminf(p.in[I_5ARE][lg * 64 + ps], -1e-4f), lim = p.in[I_5AIM][lg * 64 + ps]; const float mag = expf(dt * lre), are = mag * cosf(dt * lim), aim = mag * sinf(dt * lim);
        const float den = lre * lre + lim * lim; const float fre = ((are - 1.0f) * lre + aim * lim) / den, fim = (aim * lre - (are - 1.0f) * lim) / den;
        const float* brp = p.in[I_5BRE] + ((size_t)lg * 64 + ps) * 16 + (fq & 1) * 8; const float* bip = p.in[I_5BIM] + ((size_t)lg * 64 + ps) * 16 + (fq & 1) * 8;
        float v8[8];
#pragma unroll
        for (int jj = 0; jj < 8; ++jj) { const float br = brp[jj], bi = bip[jj]; const float bb = isim ? (fre * bi + fim * br) : (fre * br - fim * bi);
            const float hi = bf2f(f2bf(bb)); v8[jj] = (fq < 2) ? hi : (bb - hi); }
        const u32x4 pk = pack8(v8); bbfr[pt] = *(const bf16x8*)&pk; }
    bf16x8 cfr[4];
#pragma unroll
    for (int ks = 0; ks < 4; ++ks) { float v8[8];
#pragma unroll
        for (int jj = 0; jj < 8; ++jj) { const int k = ks * 32 + fq * 8 + jj; v8[jj] = k < 64 ? p.in[I_5CRE][((size_t)lg * 16 + fr) * 64 + k] : -p.in[I_5CIM][((size_t)lg * 16 + fr) * 64 + k - 64]; }
        const u32x4 pk = pack8(v8); cfr[ks] = *(const bf16x8*)&pk; }
    const float dsk = p.in[I_5D][l * 512 + g * 16 + fr];
    float s_re = 0.f, s_im = 0.f;
    u32x4 uvn = *(const u32x4*)(PROJ + (brow + fr) * PJ_LD + 4608 + g * 16 + (fq & 1) * 8);
#pragma unroll 1
    for (int st = 0; st < 132; ++st) {
        const size_t row0 = brow + st * 16;
        const u32x4 uv = uvn;
        if (st + 1 < 132) uvn = *(const u32x4*)(PROJ + (row0 + 16 + fr) * PJ_LD + 4608 + g * 16 + (fq & 1) * 8);
        const bf16x8 ufr = *(const bf16x8*)&uv;
#pragma unroll
        for (int pt = 0; pt < 8; ++pt) { const f32x4 acc = mfma16(ufr, bbfr[pt], (f32x4){0.f, 0.f, 0.f, 0.f});
#pragma unroll
            for (int j = 0; j < 4; ++j) bu[(4 * fq + j) * 132 + pt * 16 + fr] = acc[j]; }
        lds_wave_sync();
#pragma unroll
        for (int t = 0; t < 16; ++t) { const float bre = bu[t * 132 + lane], bim = bu[t * 132 + 64 + lane];
            const float nre = ab_re * s_re - ab_im * s_im + bre, nim = ab_re * s_im + ab_im * s_re + bim; s_re = nre; s_im = nim;
            sb[t * 136 + lane] = f2bf(s_re); sb[t * 136 + 64 + lane] = f2bf(s_im); }
        lds_wave_sync();
        f32x4 acc = (f32x4){0.f, 0.f, 0.f, 0.f};
#pragma unroll
        for (int ks = 0; ks < 4; ++ks) acc = mfma16(ldsfrag(sb, 136, fr, ks * 32 + fq * 8), cfr[ks], acc);
#pragma unroll
        for (int j = 0; j < 4; ++j) { const size_t row = row0 + 4 * fq + j; const float u = bf2f(PROJ[row * PJ_LD + 4608 + g * 16 + fr]);
            YP[row * 512 + g * 16 + fr] = f2bf(gelu_tanh(acc[j] + dsk * u)); }
        lds_wave_sync();
    }
}

static __device__ __forceinline__ void s5_glu_tile(const Params& p, int l, LAS unsigned char* lds, int tile, int wv) {
    const int tid = opaque_tid(wv), lane = tid & 63, w = __builtin_amdgcn_readfirstlane(tid >> 6), fr = lane & 15, fq = lane >> 4;
    LAS bf16_t* At = (LAS bf16_t*)lds;
    LAS float* ssum = (LAS float*)(lds + 66560);
    const bf16_t* YP = (const bf16_t*)(p.ws + WS_YP); bf16_t* Y = (bf16_t*)(p.ws + WS_Y); const bf16_t* Wg = (const bf16_t*)(p.ws + WS_W) + W_GLU;
    {
        const size_t row0 = (size_t)tile * 64;
#pragma unroll
        for (int i = 0; i < 8; ++i) { const int e = tid + i * NTHREADS, r = e >> 6, c8 = (e & 63) * 8; *(LAS u32x4*)(At + r * 520 + c8) = *(const u32x4*)(YP + (row0 + r) * 512 + c8); }
        __syncthreads();
        f32x4 acc[4][4];
#pragma unroll
        for (int a = 0; a < 4; ++a)
#pragma unroll
            for (int c = 0; c < 4; ++c) acc[a][c] = (f32x4){0.f, 0.f, 0.f, 0.f};
#pragma unroll 2
        for (int ks = 0; ks < 16; ++ks) {
            bf16x8 bfr[4];
#pragma unroll
            for (int nt = 0; nt < 4; ++nt) bfr[nt] = *(const bf16x8*)(Wg + (size_t)(w * 64 + nt * 16 + fr) * 512 + ks * 32 + fq * 8);
#pragma unroll
            for (int tt = 0; tt < 4; ++tt) { const bf16x8 afr = ldsfrag(At, 520, tt * 16 + fr, ks * 32 + fq * 8);
#pragma unroll
                for (int nt = 0; nt < 4; ++nt) acc[tt][nt] = mfma16(bfr[nt], afr, acc[tt][nt]); }
        }
#pragma unroll
        for (int tt = 0; tt < 4; ++tt) { float ssq = 0.f;
#pragma unroll
            for (int nt = 0; nt < 4; ++nt) { const u32x2 yy = *(const LAS u32x2*)(At + (tt * 16 + fr) * 520 + w * 64 + nt * 16 + 4 * fq);
                f32x4 v; v[0] = bflo(yy.x) * sigmoidf_(acc[tt][nt][0]); v[1] = bfhi(yy.x) * sigmoidf_(acc[tt][nt][1]); v[2] = bflo(yy.y) * sigmoidf_(acc[tt][nt][2]); v[3] = bfhi(yy.y) * sigmoidf_(acc[tt][nt][3]);
                acc[tt][nt] = v; ssq += v[0] * v[0] + v[1] * v[1] + v[2] * v[2] + v[3] * v[3]; }
            ssq += shx(ssq, 16, lane); ssq += shx(ssq, 32, lane);
            if (fq == 0) ssum[w * 64 + tt * 16 + fr] = ssq; }
        __syncthreads();
#pragma unroll
        for (int tt = 0; tt < 4; ++tt) { const int t = tt * 16 + fr; float tot = 0.f;
#pragma unroll
            for (int ww = 0; ww < 8; ++ww) tot += ssum[ww * 64 + t];
            const float rstd = rsqrtf(tot * (1.0f / 512.0f) + 1e-6f);
#pragma unroll
            for (int nt = 0; nt < 4; ++nt) { const int n0 = w * 64 + nt * 16 + 4 * fq; const f32x4 g4 = *(const f32x4*)(p.in[I_5NORM] + l * 512 + n0);
                *(u32x2*)(Y + (row0 + t) * DMIX + 1536 + n0) = pack4(ymask_on(3) ? acc[tt][nt] * rstd * g4 : (f32x4){0.f, 0.f, 0.f, 0.f}); } }
        __syncthreads();
    }
}

static __device__ __forceinline__ void zero_y_cols(const Params& p, int b, int c0, int ncols, int part, int nparts, int wv) {
    const int tid = opaque_tid(wv); bf16_t* Y = (bf16_t*)(p.ws + WS_Y);
    (void)part; (void)nparts;
#pragma unroll 1
    for (int r = tid >> 6; r < TP; r += NTHREADS / 64)
#pragma unroll 1
        for (int c = (tid & 63) * 8; c < ncols; c += 512) *(u32x4*)(Y + ((size_t)b * TP + r) * DMIX + c0 + c) = (u32x4){0u, 0u, 0u, 0u};
}
static __device__ __forceinline__ void finalize_loop(const Params& p, int l, int le, LAS unsigned char* lds, int wv) {
    LAS unsigned* slot = (LAS unsigned*)(lds + 81920);
    for (int type = 0; type < 3; ++type) {
        unsigned* qhead = (unsigned*)(p.ws + WS_FLAG) + 1216 + type * 8 + le;
        const unsigned* done = (const unsigned*)(p.ws + WS_FLAG) + 1248 + type * 64 + le * 8;
        const unsigned need = type == 0 ? 11u : (type == 1 ? 4u : 8u);
        for (;;) {
            const int tid = opaque_tid(wv);
            __syncthreads();
            if (tid == 0) slot[0] = __hip_atomic_fetch_add(qhead, 1u, __ATOMIC_RELAXED, __HIP_MEMORY_SCOPE_AGENT);
            __syncthreads();
            const unsigned item = slot[0];
            if (item >= (unsigned)(MP / 64)) break;
            if (tid < 64) {
                unsigned spins = 0;
                while ((unsigned)__builtin_amdgcn_readfirstlane((int)__hip_atomic_load(done + item / 33u, __ATOMIC_RELAXED, __HIP_MEMORY_SCOPE_AGENT)) < need) { __builtin_amdgcn_s_sleep(4); if (++spins > (1u << 22)) break; }
                __builtin_amdgcn_fence(__ATOMIC_ACQUIRE, "agent");
                asm volatile("s_waitcnt vmcnt(0)" ::: "memory");
            }
            __syncthreads();
            if (type == 0) lru_fix_tile(p, l, lds, (int)item, wv);
            else if (type == 1) s5_glu_tile(p, l, lds, (int)item, wv);
            else ssd_norm_tile(p, l, (int)item, wv);
        }
    }
}
static __device__ __forceinline__ void role_done(const Params& p, int le, int b, int type, int wv) {
    __threadfence();
    asm volatile("s_waitcnt vmcnt(0)" ::: "memory");
    __syncthreads();
    if (opaque_tid(wv) == 0) __hip_atomic_fetch_add((unsigned*)(p.ws + WS_FLAG) + 1248 + type * 64 + le * 8 + b, 1u, __ATOMIC_RELAXED, __HIP_MEMORY_SCOPE_AGENT);
}

static __device__ __forceinline__ void mixer_phase(const Params& p, int l, int le, LAS unsigned char* lds, int bid, int wv) {
    if (bid < 32) { gdn_mixer(p, l, le, bid >> 2, bid & 3, lds, wv); return; }
    if (bid < 96) { const int j = bid - 32; ssd_mixer(p, l, j >> 3, (j >> 2) & 1, j & 3, lds, wv); role_done(p, le, j >> 3, 2, wv); }
    else if (bid < 96 + NB * LRU_SEG) { gdn_helper_loop(p, l, le, lds, wv, 2);
        lru_mixer(p, l, (bid - 96) / LRU_SEG, (bid - 96) % LRU_SEG, lds, wv); role_done(p, le, (bid - 96) / LRU_SEG, 0, wv); }
    else if (bid < 96 + NB * LRU_SEG + 32) { const int j = bid - 96 - NB * LRU_SEG; s5_scan(p, l, j >> 2, j & 3, lds, wv); role_done(p, le, j >> 2, 1, wv); }
    gdn_helper_loop(p, l, le, lds, wv);
    finalize_loop(p, l, le, lds, wv);
}

#define XB_TMO      128
#define XB_XCNT(j)  (256  + 64 * (j))
#define XB_XSUB(j)  (1280 + 64 * (j))
#define XB_XGEN(j)  (2304 + 64 * (j))
#define XB_TOP      3328
#define XB_TOPGEN   3392
#define XCD_BAR_WORDS 3456
#define XB_SPIN_CAP (1u << 18)

__device__ __forceinline__ unsigned xb_ld(unsigned* p)              { return __hip_atomic_load(p, __ATOMIC_RELAXED, __HIP_MEMORY_SCOPE_AGENT); }
__device__ __forceinline__ unsigned xb_add(unsigned* p, unsigned v) { return __hip_atomic_fetch_add(p, v, __ATOMIC_RELAXED, __HIP_MEMORY_SCOPE_AGENT); }
__device__ __forceinline__ unsigned xb_xcc_id() { return (unsigned)__builtin_amdgcn_s_getreg((3 << 11) | 20) & 0xFu; }
#define XB_SPIN(cond, bar) do { unsigned _sp = 0; while (cond) { __builtin_amdgcn_s_sleep(1); \
    if ((++_sp & 255u) == 0u) { if (xb_ld(&(bar)[XB_TMO])) break; if (_sp > XB_SPIN_CAP) { atomicAdd(&(bar)[XB_TMO], 1u); break; } } } } while (0)

struct XcdBarrier {
    unsigned* bar; unsigned x;
    volatile LAS unsigned* st;
};

__device__ __forceinline__ XcdBarrier xcd_barrier_post(unsigned* bar, volatile LAS unsigned* st, bool is0) {
    XcdBarrier b; b.bar = bar; b.x = xb_xcc_id(); b.st = st;
    if (is0) (void)xb_add(&bar[XB_XCNT(b.x)], 1u);
    return b;
}
__device__ __forceinline__ void xcd_barrier_complete(unsigned* bar, unsigned x, unsigned& nloc, unsigned& nx) {
    const unsigned G = gridDim.x * gridDim.y * gridDim.z;
    unsigned sum, cnt, mine, sp = 0u;
    for (;;) {
        sum = 0u; cnt = 0u; mine = 0u;
#pragma unroll
        for (unsigned j = 0; j < 16; ++j) { const unsigned c = xb_ld(&bar[XB_XCNT(j)]); sum += c; cnt += (c > 0u) ? 1u : 0u; mine = (j == x) ? c : mine; }
        if (sum == G) break;
        __builtin_amdgcn_s_sleep(1);
        if ((++sp & 255u) == 0u) { if (xb_ld(&bar[XB_TMO])) break; if (sp > XB_SPIN_CAP) { atomicAdd(&bar[XB_TMO], 1u); break; } }
    }
    nloc = mine > 0u ? mine : 1u; nx = cnt > 0u ? cnt : 1u;
}

__device__ __forceinline__ void xcd_barrier(const XcdBarrier& b, bool is0) {
    asm volatile("s_waitcnt vmcnt(0)" ::: "memory");
    __syncthreads();
    if (is0) {
        unsigned* bar = b.bar;
        __builtin_amdgcn_s_waitcnt(0);
        unsigned nloc = b.st[0], nx = b.st[1];
        if (nloc == 0u) { xcd_barrier_complete(bar, b.x, nloc, nx); b.st[0] = nloc; b.st[1] = nx; }
        const unsigned old = xb_add(&bar[XB_XSUB(b.x)], 1u);
        const unsigned gen = old / nloc;
        if (old + 1u == (gen + 1u) * nloc) {
            __builtin_amdgcn_fence(__ATOMIC_RELEASE, "agent");
            asm volatile("s_waitcnt vmcnt(0)" ::: "memory");
            const unsigned og = xb_add(&bar[XB_TOP], 1u);
            const unsigned tg = og / nx;
            if (og + 1u == (tg + 1u) * nx) xb_add(&bar[XB_TOPGEN], 1u);
            else XB_SPIN(xb_ld(&bar[XB_TOPGEN]) == tg, bar);
            __builtin_amdgcn_fence(__ATOMIC_ACQUIRE, "agent");
            xb_add(&bar[XB_XGEN(b.x)], 1u);
            asm volatile("s_waitcnt vmcnt(0)" ::: "memory");
        } else {
            XB_SPIN(xb_ld(&bar[XB_XGEN(b.x)]) == gen, bar);
            __builtin_amdgcn_fence(__ATOMIC_ACQUIRE, "agent");
            asm volatile("s_waitcnt vmcnt(0)" ::: "memory");
        }
    }
    __syncthreads();
}


__global__ void __launch_bounds__(NTHREADS, 2) fwd_megakernel(Params p_) {
    extern __shared__ __attribute__((aligned(16))) unsigned char lds_raw[];
    LAS unsigned char* lds = (LAS unsigned char*)lds_raw;
    cg::grid_group grid = cg::this_grid();
    const int wv = __builtin_amdgcn_readfirstlane((int)threadIdx.x >> 6);
    const Params& p = *(const Params*)__builtin_amdgcn_kernarg_segment_ptr();
    (void)p_;
    typedef const __attribute__((address_space(4))) Params* ParamsK;
    unsigned char* ws = ((ParamsK)__builtin_amdgcn_kernarg_segment_ptr())->ws;
    unsigned* barw = (unsigned*)(ws + WS_BAR);
    { const int t0 = opaque_tid(wv);
      if (opaque_s(blockIdx.x) == 0) for (int i = t0; i < XCD_BAR_WORDS; i += NTHREADS) __hip_atomic_store(barw + i, 0u, __ATOMIC_RELAXED, __HIP_MEMORY_SCOPE_AGENT);
      if (opaque_s(blockIdx.x) == 1) for (int i = t0; i < 2048; i += NTHREADS) __hip_atomic_store((unsigned*)(ws + WS_FLAG) + i, 0u, __ATOMIC_RELAXED, __HIP_MEMORY_SCOPE_AGENT);
      if (t0 < 4) ((LAS unsigned*)(lds + LDS_BYTES - 16))[t0] = 0u; }
    grid.sync();
    const XcdBarrier xbar = xcd_barrier_post(barw, (volatile LAS unsigned*)(lds + LDS_BYTES - 16), opaque_tid(wv) == 0);
    for (int ph = 0; ph < NL * 10; ++ph) {
        const int l = ph / 10, k = ph % 10;
        const int G = opaque_s(gridDim.x), bid = opaque_s(blockIdx.x);
        unsigned char* wsl = ((ParamsK)__builtin_amdgcn_kernarg_segment_ptr())->ws;
        float* H = (float*)(wsl + WS_H); bf16_t* XN = (bf16_t*)(wsl + WS_XN); bf16_t* W = (bf16_t*)(wsl + WS_W);
        bf16_t* ACT = (bf16_t*)(wsl + WS_ACT); bf16_t* PROJ = (bf16_t*)(wsl + WS_PROJ); float* SM = (float*)(wsl + WS_SM); bf16_t* Y = (bf16_t*)(wsl + WS_Y);
        if (k == 0) {
            convert_layer(p, l, lds, bid, G, wv);
            if (l == 0) norm_phase<true>(p, p.in[I_F1N], wv, 0); else norm_phase<false>(p, p.in[I_F1N] + (size_t)l * DM, wv, DFF / 256);
        } else if (k == 3) {
            norm_phase<false>(p, p.in[I_MIXN] + (size_t)l * DM, wv, DFF / 256);
        } else if (k == 7) {
            norm_phase<false>(p, p.in[I_F2N] + (size_t)l * DM, wv, DMIX / 256);
        } else if (k == 5) {
            for (int rep = 0, nrep = opaque_s(MIXREP); rep < nrep; ++rep) { mixer_phase(p, l, l * MIXREP + rep, lds, bid, wv); if (rep + 1 < nrep) xcd_barrier(xbar, opaque_tid(wv) == 0); }
        } else {
            const bool isGU = (k == 1 || k == 8), isDN = (k == 2 || k == 9), isIN = (k == 4);
            const bf16_t* gA = (isGU || isIN) ? XN : (isDN ? ACT : Y);
            const size_t wo = isGU ? (k == 1 ? W_GU1 : W_GU2) : (isDN ? (k == 2 ? W_DN1 : W_DN2) : (isIN ? W_IN : W_OUT));
            const int gN = isGU ? 2 * DFF : (isIN ? NPJ : DM), gK = isDN ? DFF : ((isGU || isIN) ? DM : DMIX);
            const int emode = isGU ? 0 : (isIN ? 2 : 1);
            const pg8::Gemm g{gA, W + wo, MP, gN, gK};
            const pg8::Epi E{emode, emode != 1, isGU ? ACT : PROJ, isIN ? SM : H, isDN ? 0.5f : 1.0f, gK / 64};
            pg8::StaticOrder S; S.init(MP, gN, gK, G, bid, emode == 1);
            pg8::gemm_phase(lds, g, S, E, wv);
        }
        xcd_barrier(xbar, opaque_tid(wv) == 0);
    }
    final_phase(p, wv);
}

extern "C" void kernel_launch(void* const* d_in, const int* in_sizes, int n_in, void* d_out, int out_size, void* d_ws, size_t ws_size, hipStream_t stream) {
    static int grid = 0;
    if (grid == 0) {
        if (n_in != N_INPUTS || ws_size < WS_END) { fprintf(stderr, "kernel_launch: unexpected n_in %d or ws_size %zu (< %zu)\n", n_in, ws_size, (size_t)WS_END); }
        int dev = 0, cus = 0, per_cu = 0;
        (void)hipGetDevice(&dev);
        (void)hipDeviceGetAttribute(&cus, hipDeviceAttributeMultiprocessorCount, dev);
        (void)hipFuncSetAttribute((const void*)fwd_megakernel, hipFuncAttributeMaxDynamicSharedMemorySize, LDS_BYTES);
        (void)hipOccupancyMaxActiveBlocksPerMultiprocessor(&per_cu, (const void*)fwd_megakernel, NTHREADS, LDS_BYTES);
        if (per_cu < 1) { fprintf(stderr, "kernel_launch: occupancy query says %d blocks per CU\n", per_cu); per_cu = 1; }
        (void)hipGetLastError();
        grid = cus;
    }
    Params p{};
    for (int i = 0; i < N_INPUTS; ++i) p.in[i] = (const float*)d_in[i];
    p.out = (float*)d_out; p.ws = (unsigned char*)d_ws;
    void* args[] = {&p};
    hipError_t e = hipLaunchCooperativeKernel((const void*)fwd_megakernel, dim3(grid), dim3(NTHREADS), args, LDS_BYTES, stream);
    if (e != hipSuccess) fprintf(stderr, "cooperative launch failed: %s (grid %d)\n", hipGetErrorString(e), grid);
}
```

```cpp
#include <hip/hip_runtime.h>
#include <hip/hip_cooperative_groups.h>
#include <cstdio>
namespace cg = cooperative_groups;

#define LAS __attribute__((address_space(3)))
typedef unsigned short bf16_t;
typedef short bf16x8 __attribute__((ext_vector_type(8)));
typedef float f32x4 __attribute__((ext_vector_type(4)));
typedef float f32x2 __attribute__((ext_vector_type(2)));
typedef unsigned u32x4 __attribute__((ext_vector_type(4)));
typedef unsigned u32x2 __attribute__((ext_vector_type(2)));

constexpr int DM = 1024, NB = 8, SEQ = 2048, NL = 4, NMETA = 16, TP = 2112, MP = NB * TP  , LEAD = 48;
constexpr int DFF = 2816, DIN = 5136, NPJ = 5376  , PJ_LD = 5120, DMIX = 2048, WG = 512;
constexpr int NTHREADS = 512;
constexpr int LRU_SEG = 11, LRU_HK = 6;
constexpr int LDS_BYTES = 160 * 1024;
#ifndef MIXREP
#define MIXREP 1
#endif
#ifndef YMASK
#define YMASK 15
#endif
__device__ __forceinline__ bool ymask_on(int bit) { int m = YMASK; asm volatile("" : "+s"(m)); return ((m >> bit) & 1) != 0; }

enum { I_X = 0, I_META, I_F1N, I_F1G, I_F1U, I_F1D, I_MIXN, I_WIN, I_WOUT,
       I_LCW, I_LCB, I_LWA, I_LBA, I_LWI, I_LBI, I_LLAM, I_LNORM,
       I_GCW, I_GALOG, I_GDTB, I_GNORM,
       I_SCW, I_SCB, I_SALOG, I_SDTB, I_SD, I_SNORM,
       I_5ARE, I_5AIM, I_5LDT, I_5BRE, I_5BIM, I_5CRE, I_5CIM, I_5D, I_5GLU, I_5NORM,
       I_F2N, I_F2G, I_F2U, I_F2D, I_FINN, N_INPUTS };

constexpr size_t WS_H = 0;
constexpr size_t WS_XN = WS_H + (size_t)MP * DM * 4;
constexpr size_t WS_W = WS_XN + (size_t)MP * DM * 2;
constexpr size_t W_GU1 = 0;
constexpr size_t W_DN1 = W_GU1 + (size_t)2 * DFF * DM;
constexpr size_t W_IN = W_DN1 + (size_t)DM * DFF;
constexpr size_t W_OUT = W_IN + (size_t)NPJ * DM;
constexpr size_t W_GU2 = W_OUT + (size_t)DM * DMIX;
constexpr size_t W_DN2 = W_GU2 + (size_t)2 * DFF * DM;
constexpr size_t W_GLU = W_DN2 + (size_t)DM * DFF;
constexpr size_t W_ELEMS = W_GLU + (size_t)WG * WG;
constexpr size_t WS_R = WS_W + W_ELEMS * 2;
constexpr size_t WS_ACT = WS_R;
constexpr size_t WS_PROJ = WS_R;
constexpr size_t WS_SM = WS_PROJ + (size_t)MP * PJ_LD * 2;
constexpr size_t WS_Y = WS_SM + (size_t)MP * 16 * 4;
constexpr size_t WS_YP = WS_Y + (size_t)MP * DMIX * 2;
constexpr size_t WS_BAR = WS_YP + (size_t)MP * WG * 2;
constexpr size_t WS_PART = WS_BAR + 16384;
constexpr size_t WS_CAR = WS_PART + (size_t)11 * 512 * DM * 4;
constexpr size_t WS_SSQ = WS_CAR + (size_t)NB * 11 * 2 * WG * 4;
constexpr size_t WS_TA = WS_SSQ + (size_t)MP * 16 * 4;
constexpr size_t WS_FLAG = WS_TA + (size_t)32 * 33 * 2 * 4096 * 2;
constexpr size_t WS_END = WS_FLAG + 8192;

struct Params { const float* in[N_INPUTS]; float* out; unsigned char* ws; };

typedef __bf16 bf16x2_t __attribute__((ext_vector_type(2)));
__device__ __forceinline__ unsigned cvt_pk_bf16(float lo, float hi) { const f32x2 v = {lo, hi}; const bf16x2_t b = __builtin_convertvector(v, bf16x2_t); return __builtin_bit_cast(unsigned, b); }
__device__ __forceinline__ float bf2f(bf16_t b) { return __uint_as_float(((unsigned)b) << 16); }
__device__ __forceinline__ bf16_t f2bf(float f) { return (bf16_t)(cvt_pk_bf16(f, 0.f) & 0xffffu); }
__device__ __forceinline__ float sigmoidf_(float x) { return __builtin_amdgcn_rcpf(1.0f + __expf(-x)); }
__device__ __forceinline__ float siluf_(float x) { return x * __builtin_amdgcn_rcpf(1.0f + __expf(-x)); }
__device__ __forceinline__ float softplusf_(float x) { const float e = __expf(x); return x > 20.f ? x : (x < -15.f ? e : __logf(1.0f + e)); }
__device__ __forceinline__ float neg_expm1(float x) { const float ser = -x * (1.0f + x * 0.5f * (1.0f + x * (1.0f / 3.0f) * (1.0f + x * 0.25f * (1.0f + x * 0.2f * (1.0f + x * (1.0f / 6.0f)))))); return x > -0.5f ? ser : 1.0f - __expf(x); }
__device__ __forceinline__ float gelu_tanh(float x) { const float u = 0.7978845608028654f * (x + 0.044715f * x * x * x); return x * __builtin_amdgcn_rcpf(1.0f + __expf(-2.0f * u)); }

__device__ __forceinline__ int opaque_tid(int wv) { int t; asm volatile("v_mbcnt_lo_u32_b32 %0, -1, 0\n\tv_mbcnt_hi_u32_b32 %0, -1, %0" : "=v"(t)); return (wv << 6) | t; }
__device__ __forceinline__ int opaque_v0() { int z = 0; asm volatile("" : "+v"(z)); return z; }
__device__ __forceinline__ int opaque_s(int v) { asm volatile("" : "+s"(v)); return v; }

__device__ __forceinline__ float shx(float v, int mask, int lane) { return __int_as_float(__builtin_amdgcn_ds_bpermute((lane ^ mask) << 2, __float_as_int(v))); }
__device__ __forceinline__ float shidx(float v, int src) { return __int_as_float(__builtin_amdgcn_ds_bpermute(src << 2, __float_as_int(v))); }

namespace pg8 {
constexpr int BM = 256, BK = 64, HALF = 128, HTB = HALF * BK * 2, STAGE_BYTES = 8 * HTB, NXCD = 8, WGM = 8;
__host__ __device__ __forceinline__ int lds_byte(int r, int c) { const int st = (r >> 4) * 2 + (c >> 5), rr = r & 15, cc = c & 31, ob = rr * 64 + cc * 2; return st * 1024 + (ob ^ (((ob >> 9) & 1) << 5)); }
__host__ __device__ __forceinline__ void stage_rc(int b, int& R, int& C) { const int st = b / 1024, sb = b % 1024, swz = sb ^ (((sb >> 9) & 1) << 5); R = (st >> 1) * 16 + swz / 64; C = (st & 1) * 32 + (swz % 64) / 2; }
__host__ __device__ __forceinline__ int perm32(int rho) { const int n = rho >> 4, i = rho & 15; return 8 * (i >> 2) + 4 * n + (i & 3); }

struct Unit { int pm, pn, k0, nt; };
struct Gemm { const bf16_t* A; const bf16_t* Bt; int M, N, K; };

struct StaticOrder {
    int nMf, nN, nwg, G, c, ntk, npk, ntail;
    __device__ void init(int M, int N, int K, int G_, int c_, bool split) { const int nM = M / BM; nN = N / BM; G = G_; c = c_; ntk = K / BK;
        nMf = split ? 64 : nM; npk = split ? ntk / 4 : 0; ntail = (nM - nMf) * nN; nwg = nMf * nN; }
    __device__ bool next(int i, Unit& u) const {
        const long L = (long)i * G + c;
        if (L >= nwg) { const int idx = (int)(L - nwg); if (idx >= ntail * npk) return false;
            const int tile = idx / npk, piece = idx - tile * npk; u.pm = nMf + tile / nN; u.pn = tile % nN; u.k0 = piece * 4; u.nt = 4; return true; }
        int wgid = (int)L; { const int q = nwg / NXCD, r = nwg % NXCD, xcd = wgid % NXCD, off = wgid / NXCD; wgid = (xcd < r ? xcd * (q + 1) : r * (q + 1) + (xcd - r) * q) + off; }
        const int nig = WGM * nN, gid = wgid / nig, fm = gid * WGM, gsz = (nMf - fm) < WGM ? (nMf - fm) : WGM;
        u.pm = fm + ((wgid % nig) % gsz); u.pn = (wgid % nig) / gsz; u.k0 = 0; u.nt = ntk; return true;
    }
};

template <class Epi, class Sched>
__device__ __forceinline__ void gemm_phase(LAS unsigned char* lds, const Gemm g, const Sched& S, const Epi& E, int wv) {
    const int tid = opaque_tid(wv), wid = __builtin_amdgcn_readfirstlane(tid >> 6), lane = tid & 63, wr = wid >> 2, wc = wid & 3, fr = lane & 15, fq = lane >> 4;
    const int K = g.K;
    unsigned voffA[2], voffB[2];
#pragma unroll
    for (int i = 0; i < 2; ++i) { int R, C; stage_rc(tid * 16 + i * 8192, R, C); const int Rb = E.perm ? ((R & ~31) + perm32(R & 31)) : R;
        voffA[i] = (unsigned)(R * K + C) * 2u; voffB[i] = (unsigned)(Rb * K + C) * 2u; }
    const size_t kstep = (size_t)(BK * 2);
    const size_t hstep = (size_t)HALF * K * 2;
    const size_t tstep = 2 * hstep;
    const unsigned ldsw = (unsigned)wid * 1024u;
    const int aoff = lds_byte(wr * 64 + fr, fq * 8), boff = lds_byte(wc * 32 + fr, fq * 8);
#define PG8_SA(b, h) (((b) * 2 + (h)) * HTB)
#define PG8_SB(b, h) ((4 + (b) * 2 + (h)) * HTB)
#define PG8_STAGE(bufoff, gbase, voff) do { _Pragma("unroll") for (int _i = 0; _i < 2; ++_i) \
        __builtin_amdgcn_global_load_lds((const unsigned*)((const char*)(gbase) + (voff)[_i]), (LAS unsigned*)(lds + (bufoff) + ldsw + _i * 8192), 16, 0, 0); } while (0)
#define PG8_LDA(dst, b, h) do { _Pragma("unroll") for (int m = 0; m < 4; ++m) _Pragma("unroll") for (int k = 0; k < 2; ++k) dst[m][k] = *(const LAS bf16x8*)(lds + PG8_SA(b, h) + aoff + m * 2048 + k * 1024); } while (0)
#define PG8_LDB(dst, b, h) do { _Pragma("unroll") for (int n = 0; n < 2; ++n) _Pragma("unroll") for (int k = 0; k < 2; ++k) dst[n][k] = *(const LAS bf16x8*)(lds + PG8_SB(b, h) + boff + n * 2048 + k * 1024); } while (0)
#define PG8_MMA(ai, bj, At, Bt) do { __builtin_amdgcn_s_setprio(1); _Pragma("unroll") for (int m = 0; m < 4; ++m) _Pragma("unroll") for (int n = 0; n < 2; ++n) _Pragma("unroll") for (int k = 0; k < 2; ++k) \
        acc[ai][bj][m][n] = __builtin_amdgcn_mfma_f32_16x16x32_bf16(Bt[n][k], At[m][k], acc[ai][bj][m][n], 0, 0, 0); __builtin_amdgcn_s_setprio(0); } while (0)
#define PG8_WAIT_V(n) asm volatile("s_waitcnt vmcnt(" #n ")" ::: "memory")
#define PG8_WAIT_L(n) asm volatile("s_waitcnt lgkmcnt(" #n ")" ::: "memory")
#define PG8_BAR __builtin_amdgcn_s_barrier()
#define PG8_SCHED __builtin_amdgcn_sched_barrier(0)
    Unit cur, nxt; int ui = 0;
    if (!S.next(0, cur)) return;
    f32x4 acc[2][2][4][2];
#pragma unroll
    for (int a = 0; a < 2; ++a)
#pragma unroll
        for (int b = 0; b < 2; ++b)
#pragma unroll
            for (int m = 0; m < 4; ++m)
#pragma unroll
                for (int n = 0; n < 2; ++n) acc[a][b][m][n] = (f32x4){0.f, 0.f, 0.f, 0.f};
    bf16x8 At[4][2], B0[2][2], B1[2][2];
    const char* cA = (const char*)g.A + (size_t)cur.pm * tstep + (size_t)cur.k0 * kstep; const char* cB = (const char*)g.Bt + (size_t)cur.pn * tstep + (size_t)cur.k0 * kstep;
    PG8_STAGE(PG8_SB(0, 0), cB, voffB); PG8_STAGE(PG8_SA(0, 0), cA, voffA); PG8_STAGE(PG8_SB(0, 1), cB + hstep, voffB); PG8_STAGE(PG8_SA(0, 1), cA + hstep, voffA);
    if (wr == 1) PG8_BAR;
    PG8_WAIT_V(4); PG8_BAR;
    PG8_STAGE(PG8_SB(1, 0), cB + kstep, voffB); PG8_STAGE(PG8_SA(1, 0), cA + kstep, voffA); PG8_STAGE(PG8_SB(1, 1), cB + hstep + kstep, voffB);
    PG8_WAIT_V(6); PG8_BAR;
    for (;;) {
        const bool has_next = S.next(ui + 1, nxt);
        const char* nA = has_next ? (const char*)g.A + (size_t)nxt.pm * tstep + (size_t)nxt.k0 * kstep : cA; const char* nB = has_next ? (const char*)g.Bt + (size_t)nxt.pn * tstep + (size_t)nxt.k0 * kstep : cB;
        const int nt = cur.nt;
        for (int t = 0; t < nt; t += 2) {
            const bool last = (t == nt - 2);
            const char* a1 = cA + (size_t)(t + 1) * kstep;
            const char* a2 = last ? nA : cA + (size_t)(t + 2) * kstep; const char* b2 = last ? nB : cB + (size_t)(t + 2) * kstep;
            const char* a3 = a2 + kstep; const char* b3 = b2 + kstep;
            PG8_LDB(B0, 0, 0); PG8_SCHED; PG8_LDA(At, 0, 0); PG8_STAGE(PG8_SA(1, 1), a1 + hstep, voffA);
            PG8_WAIT_L(8); PG8_BAR; PG8_WAIT_L(0); PG8_MMA(0, 0, At, B0); PG8_BAR; PG8_SCHED;
            PG8_LDB(B1, 0, 1); PG8_STAGE(PG8_SB(0, 0), b2, voffB);
            PG8_BAR; PG8_WAIT_L(0); PG8_MMA(0, 1, At, B1); PG8_BAR;
            PG8_LDA(At, 0, 1); PG8_STAGE(PG8_SA(0, 0), a2, voffA);
            PG8_BAR; PG8_WAIT_L(0); PG8_MMA(1, 0, At, B0); PG8_BAR; PG8_SCHED;
            PG8_STAGE(PG8_SB(0, 1), b2 + hstep, voffB);
            PG8_WAIT_V(6); PG8_BAR; PG8_MMA(1, 1, At, B1); PG8_BAR;
            PG8_LDB(B0, 1, 0); PG8_SCHED; PG8_LDA(At, 1, 0); PG8_STAGE(PG8_SA(0, 1), a2 + hstep, voffA);
            PG8_WAIT_L(8); PG8_BAR; PG8_WAIT_L(0); PG8_MMA(0, 0, At, B0); PG8_BAR; PG8_SCHED;
            PG8_LDB(B1, 1, 1); PG8_STAGE(PG8_SB(1, 0), b3, voffB);
            PG8_BAR; PG8_WAIT_L(0); PG8_MMA(0, 1, At, B1); PG8_BAR;
            PG8_LDA(At, 1, 1); PG8_STAGE(PG8_SA(1, 0), a3, voffA);
            PG8_BAR; PG8_WAIT_L(0); PG8_MMA(1, 0, At, B0); PG8_BAR; PG8_SCHED;
            PG8_STAGE(PG8_SB(1, 1), b3 + hstep, voffB);
            PG8_WAIT_V(6); PG8_BAR; PG8_MMA(1, 1, At, B1); PG8_BAR;
        }
        E(acc, cur, wr, wc, fr, fq);
        if (!has_next) break;
#pragma unroll
        for (int a = 0; a < 2; ++a)
#pragma unroll
            for (int b = 0; b < 2; ++b)
#pragma unroll
                for (int m = 0; m < 4; ++m)
#pragma unroll
                    for (int n = 0; n < 2; ++n) acc[a][b][m][n] = (f32x4){0.f, 0.f, 0.f, 0.f};
        cur = nxt; cA = nA; cB = nB; ++ui;
    }
    PG8_WAIT_V(0);
    if (wr == 0) PG8_BAR;
    PG8_BAR;
#undef PG8_SA
#undef PG8_SB
#undef PG8_STAGE
#undef PG8_LDA
#undef PG8_LDB
#undef PG8_MMA
#undef PG8_WAIT_V
#undef PG8_WAIT_L
#undef PG8_BAR
#undef PG8_SCHED
}

struct Epi {
    int mode;
    bool perm;
    bf16_t* O; float* F; float scale; int ntk_full;
    __device__ __forceinline__ void operator()(const f32x4 (&acc)[2][2][4][2], const Unit& u, int wr, int wc, int fr, int fq) const {
        const int row0 = u.pm * BM + wr * 64 + fr;
        if (mode == 0) {
            const int col0 = u.pn * 128 + wc * 32 + 8 * fq;
#pragma unroll
            for (int ai = 0; ai < 2; ++ai)
#pragma unroll
                for (int m = 0; m < 4; ++m) { bf16_t* rowp = O + (size_t)(row0 + ai * HALF + m * 16) * DFF + col0;
                    float v[8];
#pragma unroll
                    for (int n = 0; n < 2; ++n)
#pragma unroll
                        for (int j = 0; j < 4; ++j) { const float gt = acc[ai][0][m][n][j], up = acc[ai][1][m][n][j]; v[n * 4 + j] = siluf_(gt) * up; }
                    u32x4 w; w.x = cvt_pk_bf16(v[0], v[1]); w.y = cvt_pk_bf16(v[2], v[3]); w.z = cvt_pk_bf16(v[4], v[5]); w.w = cvt_pk_bf16(v[6], v[7]);
                    *(u32x4*)rowp = w; }
        } else if (mode == 1) {
            const int col0 = u.pn * BM + wc * 32 + 4 * fq;
#pragma unroll
            for (int ai = 0; ai < 2; ++ai)
#pragma unroll
                for (int m = 0; m < 4; ++m) { float* rowp = F + (size_t)(row0 + ai * HALF + m * 16) * DM + col0;
#pragma unroll
                    for (int bj = 0; bj < 2; ++bj)
#pragma unroll
                        for (int n = 0; n < 2; ++n) { float* q = rowp + bj * HALF + n * 16; const f32x4 v = acc[ai][bj][m][n] * scale;
                            if (u.nt == ntk_full) { *(f32x4*)q = *(f32x4*)q + v; }
                            else { float* PART = (float*)((unsigned char*)F + (WS_PART - WS_H)); *(f32x4*)(PART + (size_t)(u.k0 >> 2) * (512 * DM) + (size_t)(row0 + ai * HALF + m * 16 - 64 * BM) * DM + (col0 + bj * HALF + n * 16)) = v; } } }
        } else {
            if (u.pn < 20) {
                const int col0 = u.pn * BM + wc * 32 + 8 * fq;
#pragma unroll
                for (int ai = 0; ai < 2; ++ai)
#pragma unroll
                    for (int m = 0; m < 4; ++m) { bf16_t* rowp = O + (size_t)(row0 + ai * HALF + m * 16) * PJ_LD + col0;
#pragma unroll
                        for (int bj = 0; bj < 2; ++bj) { const f32x4 v0 = acc[ai][bj][m][0], v1 = acc[ai][bj][m][1];
                            u32x4 w; w.x = cvt_pk_bf16(v0[0], v0[1]); w.y = cvt_pk_bf16(v0[2], v0[3]); w.z = cvt_pk_bf16(v1[0], v1[1]); w.w = cvt_pk_bf16(v1[2], v1[3]);
                            *(u32x4*)(rowp + bj * HALF) = w; } }
            } else if (wc == 0 && fq < 2) {
#pragma unroll
                for (int ai = 0; ai < 2; ++ai)
#pragma unroll
                    for (int m = 0; m < 4; ++m) { float* rowp = F + (size_t)(row0 + ai * HALF + m * 16) * 16 + 8 * fq;
                        *(f32x4*)(rowp) = acc[ai][0][m][0]; *(f32x4*)(rowp + 4) = acc[ai][0][m][1]; }
            }
        }
    }
};
}

template <int MODE>
__device__ __forceinline__ void convert_tiles(const float* src, const float* src2, bf16_t* dst, int K, int Ns, int Nd, LAS unsigned char* lds, int wi, int nw, int wv) {
    LAS float* tile = (LAS float*)lds;
    const int tid = opaque_tid(wv), tn = Nd / 64, tk = K / 64, ntile = tn * tk;
    f32x4 pre[2];
    auto issue = [&](int t) {
        const int n0 = (t % tn) * 64, k0 = (t / tn) * 64;
#pragma unroll
        for (int i = 0; i < 2; ++i) {
            const int e = tid + i * NTHREADS, kk = e >> 4, ng = (e & 15) * 4, nd = n0 + ng;
            const float* s = src; int ns = nd;
            if (MODE == 1) { const int tl = nd >> 8, w = nd & 255; if (w < 128) { ns = tl * 128 + w; } else { s = src2; ns = tl * 128 + w - 128; } }
            if (MODE == 2) { if (nd < 3072) ns = nd; else if (nd < 4608) ns = nd + 8; else if (nd < 5120) ns = nd + 16; else if (nd < 5128) ns = nd - 2048; else if (nd < 5136) ns = nd - 512; else ns = -1; }
            pre[i] = (f32x4){0.f, 0.f, 0.f, 0.f};
            if (ns >= 0) pre[i] = *(const f32x4*)(s + (size_t)(k0 + kk) * Ns + ns);
        }
    };
    if (wi < ntile) issue(wi);
    for (int t = wi; t < ntile; t += nw) {
        const int n0 = (t % tn) * 64, k0 = (t / tn) * 64;
#pragma unroll
        for (int i = 0; i < 2; ++i) { const int e = tid + i * NTHREADS, kk = e >> 4, ng = (e & 15) * 4;
            tile[kk * 65 + ng + 0] = pre[i][0]; tile[kk * 65 + ng + 1] = pre[i][1]; tile[kk * 65 + ng + 2] = pre[i][2]; tile[kk * 65 + ng + 3] = pre[i][3]; }
        if (t + nw < ntile) issue(t + nw);
        __syncthreads();
        { const int kg = tid & 7, n = tid >> 3;
          float v[8];
#pragma unroll
          for (int i = 0; i < 8; ++i) v[i] = tile[(kg * 8 + i) * 65 + n];
          u32x4 w; w.x = cvt_pk_bf16(v[0], v[1]); w.y = cvt_pk_bf16(v[2], v[3]); w.z = cvt_pk_bf16(v[4], v[5]); w.w = cvt_pk_bf16(v[6], v[7]);
          *(u32x4*)(dst + (size_t)(n0 + n) * K + k0 + kg * 8) = w; }
        __syncthreads();
    }
}

static __device__ __forceinline__ void convert_layer(const Params& p, int l, LAS unsigned char* lds, int wi, int nw, int wv) {
    bf16_t* W = (bf16_t*)(p.ws + WS_W);
    convert_tiles<1>(p.in[I_F1G] + (size_t)l * DM * DFF, p.in[I_F1U] + (size_t)l * DM * DFF, W + W_GU1, DM, DFF, 2 * DFF, lds, wi, nw, wv);
    convert_tiles<0>(p.in[I_F1D] + (size_t)l * DFF * DM, nullptr, W + W_DN1, DFF, DM, DM, lds, wi, nw, wv);
    convert_tiles<2>(p.in[I_WIN] + (size_t)l * DM * DIN, nullptr, W + W_IN, DM, DIN, NPJ, lds, wi, nw, wv);
    convert_tiles<0>(p.in[I_WOUT] + (size_t)l * DMIX * DM, nullptr, W + W_OUT, DMIX, DM, DM, lds, wi, nw, wv);
    convert_tiles<1>(p.in[I_F2G] + (size_t)l * DM * DFF, p.in[I_F2U] + (size_t)l * DM * DFF, W + W_GU2, DM, DFF, 2 * DFF, lds, wi, nw, wv);
    convert_tiles<0>(p.in[I_F2D] + (size_t)l * DFF * DM, nullptr, W + W_DN2, DFF, DM, DM, lds, wi, nw, wv);
    convert_tiles<0>(p.in[I_5GLU] + (size_t)l * WG * WG, nullptr, W + W_GLU, WG, WG, WG, lds, wi, nw, wv);
}

template <bool INIT>
static __device__ __forceinline__ void norm_phase(const Params& p, const float* gain, int wv, int npk) {
    float* H = (float*)(p.ws + WS_H); bf16_t* XN = (bf16_t*)(p.ws + WS_XN);
    const int tid = opaque_tid(wv), lane = tid & 63, gw = opaque_s(blockIdx.x) * 8 + (tid >> 6), nw = gridDim.x * 8;
    f32x4 g[4];
#pragma unroll
    for (int i = 0; i < 4; ++i) g[i] = *(const f32x4*)(gain + 4 * lane + 256 * i);
    f32x4 nxt[4];
    if (!INIT && gw < MP) {
#pragma unroll
        for (int i = 0; i < 4; ++i) nxt[i] = *(const f32x4*)(H + (size_t)gw * DM + 4 * lane + 256 * i);
    }
    for (int r = gw; r < MP; r += nw) {
        f32x4 v[4];
        if (INIT) {
            const int b = r / TP, tp = r % TP;
            const float* src = nullptr;
            if (tp >= LEAD + NMETA) src = p.in[I_X] + ((size_t)b * SEQ + (tp - LEAD - NMETA)) * DM;
            else if (tp >= LEAD) src = p.in[I_META] + (size_t)(tp - LEAD) * DM;
#pragma unroll
            for (int i = 0; i < 4; ++i) { v[i] = src ? *(const f32x4*)(src + 4 * lane + 256 * i) : (f32x4){0.f, 0.f, 0.f, 0.f}; *(f32x4*)(H + (size_t)r * DM + 4 * lane + 256 * i) = v[i]; }
        } else {
#pragma unroll
            for (int i = 0; i < 4; ++i) v[i] = nxt[i];
            if (r + nw < MP) {
#pragma unroll
                for (int i = 0; i < 4; ++i) nxt[i] = *(const f32x4*)(H + (size_t)(r + nw) * DM + 4 * lane + 256 * i);
            }
            if (r >= 64 * 256 && npk > 0) {
                const float* PART = (const float*)(p.ws + WS_PART) + (size_t)(r - 64 * 256) * DM + 4 * lane;
                for (int q = 0; q < npk; ++q)
#pragma unroll
                    for (int i = 0; i < 4; ++i) v[i] = v[i] + *(const f32x4*)(PART + (size_t)q * (512 * DM) + 256 * i);
#pragma unroll
                for (int i = 0; i < 4; ++i) *(f32x4*)(H + (size_t)r * DM + 4 * lane + 256 * i) = v[i];
            }
        }
        float s = 0.f;
#pragma unroll
        for (int i = 0; i < 4; ++i) s += v[i][0] * v[i][0] + v[i][1] * v[i][1] + v[i][2] * v[i][2] + v[i][3] * v[i][3];
#pragma unroll
        for (int o = 32; o >= 1; o >>= 1) s += shx(s, o, lane);
        const float rstd = rsqrtf(s * (1.0f / DM) + 1e-6f);
#pragma unroll
        for (int i = 0; i < 4; ++i) { const f32x4 y = v[i] * rstd * g[i]; u32x2 w; w.x = cvt_pk_bf16(y[0], y[1]); w.y = cvt_pk_bf16(y[2], y[3]);
            *(u32x2*)(XN + (size_t)r * DM + 4 * lane + 256 * i) = w; }
    }
}
static __device__ __forceinline__ void final_phase(const Params& p, int wv) {
    const float* H = (const float*)(p.ws + WS_H); const float* gain = p.in[I_FINN];
    const int tid = opaque_tid(wv), lane = tid & 63, gw = opaque_s(blockIdx.x) * 8 + (tid >> 6), nw = gridDim.x * 8;
    f32x4 g[4];
#pragma unroll
    for (int i = 0; i < 4; ++i) g[i] = *(const f32x4*)(gain + 4 * lane + 256 * i);
    f32x4 nxt[4];
    if (gw < NB * SEQ) { const size_t r0 = (size_t)(gw / SEQ) * TP + LEAD + NMETA + gw % SEQ;
#pragma unroll
        for (int i = 0; i < 4; ++i) nxt[i] = *(const f32x4*)(H + r0 * DM + 4 * lane + 256 * i); }
    for (int o = gw; o < NB * SEQ; o += nw) {
        const int b = o / SEQ, t = o % SEQ; const size_t r = (size_t)b * TP + LEAD + NMETA + t;
        f32x4 v[4]; float s = 0.f;
#pragma unroll
        for (int i = 0; i < 4; ++i) v[i] = nxt[i];
        if (o + nw < NB * SEQ) { const int o2 = o + nw; const size_t r2 = (size_t)(o2 / SEQ) * TP + LEAD + NMETA + o2 % SEQ;
#pragma unroll
            for (int i = 0; i < 4; ++i) nxt[i] = *(const f32x4*)(H + r2 * DM + 4 * lane + 256 * i); }
        if (r >= 64 * 256) { const float* PART = (const float*)(p.ws + WS_PART) + (r - 64 * 256) * DM + 4 * lane;
            for (int q = 0; q < DFF / 256; ++q)
#pragma unroll
                for (int i = 0; i < 4; ++i) v[i] = v[i] + *(const f32x4*)(PART + (size_t)q * (512 * DM) + 256 * i); }
#pragma unroll
        for (int i = 0; i < 4; ++i) s += v[i][0] * v[i][0] + v[i][1] * v[i][1] + v[i][2] * v[i][2] + v[i][3] * v[i][3];
#pragma unroll
        for (int q = 32; q >= 1; q >>= 1) s += shx(s, q, lane);
        const float rstd = rsqrtf(s * (1.0f / DM) + 1e-6f);
#pragma unroll
        for (int i = 0; i < 4; ++i) *(f32x4*)(p.out + (size_t)o * DM + 4 * lane + 256 * i) = v[i] * rstd * g[i];
    }
}

__device__ __forceinline__ f32x4 mfma16(bf16x8 a, bf16x8 b, f32x4 c) { return __builtin_amdgcn_mfma_f32_16x16x32_bf16(a, b, c, 0, 0, 0); }
__device__ __forceinline__ bf16x8 ldsfrag(const LAS bf16_t* M, int ld, int r, int k) { return *(const LAS bf16x8*)(M + r * ld + k); }
template <int K> __device__ __forceinline__ f32x4 mma_n(const LAS bf16_t* A, int lda, int r0, const LAS bf16_t* Bt, int ldb, int c0, int fr, int fq, f32x4 acc) {
#pragma unroll
    for (int k = 0; k < K; k += 32) acc = mfma16(ldsfrag(A, lda, r0 + fr, k + fq * 8), ldsfrag(Bt, ldb, c0 + fr, k + fq * 8), acc);
    return acc;
}
template <int K> __device__ __forceinline__ f32x4 mma_t(const LAS bf16_t* A, int lda, int r0, const LAS bf16_t* Bt, int ldb, int c0, int fr, int fq, f32x4 acc) {
#pragma unroll
    for (int k = 0; k < K; k += 32) acc = mfma16(ldsfrag(Bt, ldb, c0 + fr, k + fq * 8), ldsfrag(A, lda, r0 + fr, k + fq * 8), acc);
    return acc;
}
__device__ __forceinline__ float bflo(unsigned u) { return __uint_as_float(u << 16); }
__device__ __forceinline__ float bfhi(unsigned u) { return __uint_as_float(u & 0xffff0000u); }
__device__ __forceinline__ void unpack8(const u32x4 v, float (&x)[8]) { x[0] = bflo(v.x); x[1] = bfhi(v.x); x[2] = bflo(v.y); x[3] = bfhi(v.y); x[4] = bflo(v.z); x[5] = bfhi(v.z); x[6] = bflo(v.w); x[7] = bfhi(v.w); }
__device__ __forceinline__ u32x4 pack8(const float (&x)[8]) { u32x4 w; w.x = cvt_pk_bf16(x[0], x[1]); w.y = cvt_pk_bf16(x[2], x[3]); w.z = cvt_pk_bf16(x[4], x[5]); w.w = cvt_pk_bf16(x[6], x[7]); return w; }
__device__ __forceinline__ u32x2 pack4(const f32x4 v) { u32x2 w; w.x = cvt_pk_bf16(v[0], v[1]); w.y = cvt_pk_bf16(v[2], v[3]); return w; }
__device__ __forceinline__ void lds_wave_sync() { asm volatile("s_waitcnt lgkmcnt(0)" ::: "memory"); }
__device__ __forceinline__ float wave_incl_scan(float v, int lane) {
#pragma unroll
    for (int o = 1; o < 64; o <<= 1) { const float t = shidx(v, lane - o); if (lane >= o) v += t; }
    return v;
}

static __device__ __forceinline__ void gdn_qk_prepass(const Params& p, int l, int bid, int G, int wv) {
    const bf16_t* PROJ = (const bf16_t*)(p.ws + WS_PROJ); bf16_t* QK = (bf16_t*)(p.ws + WS_XN);
    for (int item = bid; item < NB * 33; item += G) {
        const int b = item / 33, n = item % 33; const size_t brow = (size_t)b * TP; const int tp0 = n * 64;
#pragma unroll 1
        for (int pass = 0; pass < 2; ++pass) {
            const int tid = opaque_tid(wv), lane = tid & 63, co = tid & 127, tg = (tid >> 7) + pass * 4;
            const float* cwp = p.in[I_GCW] + (size_t)l * 4 * 1536 + co * 8;
            float cw[4][8];
#pragma unroll
            for (int j = 0; j < 4; ++j) { const f32x4 a0 = *(const f32x4*)(cwp + j * 1536), a1 = *(const f32x4*)(cwp + j * 1536 + 4);
                cw[j][0] = a0[0]; cw[j][1] = a0[1]; cw[j][2] = a0[2]; cw[j][3] = a0[3]; cw[j][4] = a1[0]; cw[j][5] = a1[1]; cw[j][6] = a1[2]; cw[j][7] = a1[3]; }
            const bf16_t* colbase = PROJ + brow * PJ_LD + 1024 + co * 8;
            u32x4 xr[11];
#pragma unroll
            for (int i = 0; i < 11; ++i) { const int tp = tp0 + tg * 8 - 3 + i; xr[i] = (tp >= 0) ? *(const u32x4*)(colbase + (size_t)tp * PJ_LD) : (u32x4){0u, 0u, 0u, 0u}; }
            const float qs = co < 64 ? 0.08838834764831845f : 1.0f;
#pragma unroll
            for (int t = 0; t < 8; ++t) {
                float o[8];
#pragma unroll
                for (int c = 0; c < 8; ++c) o[c] = 0.f;
#pragma unroll
                for (int j = 0; j < 4; ++j) { float x[8]; unpack8(xr[t + j], x);
#pragma unroll
                    for (int c = 0; c < 8; ++c) o[c] += cw[j][c] * x[c]; }
                float ss = 0.f;
#pragma unroll
                for (int c = 0; c < 8; ++c) { o[c] = siluf_(o[c]); ss += o[c] * o[c]; }
                ss += shx(ss, 1, lane); ss += shx(ss, 2, lane); ss += shx(ss, 4, lane); ss += shx(ss, 8, lane);
                const float rn = rsqrtf(ss + 1e-6f) * qs;
#pragma unroll
                for (int c = 0; c < 8; ++c) o[c] *= rn;
                *(u32x4*)(QK + (brow + tp0 + tg * 8 + t) * DM + co * 8) = pack8(o);
            }
        }
    }
}

static __device__ __forceinline__ void gdn_produce(const Params& p, int l, int le, int bh, int n, LAS unsigned char* lds, int wv) {
    const int tid = opaque_tid(wv), lane = tid & 63, w = __builtin_amdgcn_readfirstlane(tid >> 6), fr = lane & 15, fq = lane >> 4;
    const int b = bh >> 2, h = bh & 3;
    LAS bf16_t* Qs = (LAS bf16_t*)(lds);
    LAS bf16_t* Ks = (LAS bf16_t*)(lds + 17408);
    LAS bf16_t* As = (LAS bf16_t*)(lds + 34816);
    LAS bf16_t* Tm = (LAS bf16_t*)(lds + 44032);
    LAS float* Lm = (LAS float*)(lds + 53248);
    LAS float* gc = (LAS float*)(lds + 70656);
    LAS float* bt = gc + 64;
    const bf16_t* PROJ = (const bf16_t*)(p.ws + WS_PROJ); const float* SM = (const float*)(p.ws + WS_SM);
    const size_t brow = (size_t)b * TP;
    const int tp0 = n * 64;
    if (tid < 256) {
        const int seg = tid >> 7, idx = tid & 127, tg = idx >> 4, oc = idx & 15;
        const float* cwp = p.in[I_GCW] + (size_t)l * 4 * 1536 + seg * 512 + h * 128 + oc * 8;
        const bf16_t* colbase = PROJ + brow * PJ_LD + 1024 + seg * 512 + h * 128 + oc * 8;
        float cw[4][8];
#pragma unroll
        for (int j = 0; j < 4; ++j) { const f32x4 a0 = *(const f32x4*)(cwp + j * 1536), a1 = *(const f32x4*)(cwp + j * 1536 + 4);
            cw[j][0] = a0[0]; cw[j][1] = a0[1]; cw[j][2] = a0[2]; cw[j][3] = a0[3]; cw[j][4] = a1[0]; cw[j][5] = a1[1]; cw[j][6] = a1[2]; cw[j][7] = a1[3]; }
        u32x4 xr[11];
#pragma unroll
        for (int i = 0; i < 11; ++i) { const int tp = tp0 + tg * 8 - 3 + i; xr[i] = (tp >= 0) ? *(const u32x4*)(colbase + (size_t)tp * PJ_LD) : (u32x4){0u, 0u, 0u, 0u}; }
        LAS bf16_t* dst = seg == 0 ? Qs : Ks;
#pragma unroll
        for (int t = 0; t < 8; ++t) {
            float o[8];
#pragma unroll
            for (int c = 0; c < 8; ++c) o[c] = 0.f;
#pragma unroll
            for (int j = 0; j < 4; ++j) { float x[8]; unpack8(xr[t + j], x);
#pragma unroll
                for (int c = 0; c < 8; ++c) o[c] += cw[j][c] * x[c]; }
            float ss = 0.f;
#pragma unroll
            for (int c = 0; c < 8; ++c) { o[c] = siluf_(o[c]); ss += o[c] * o[c]; }
            ss += shx(ss, 1, lane); ss += shx(ss, 2, lane); ss += shx(ss, 4, lane); ss += shx(ss, 8, lane);
            const float rn = rsqrtf(ss + 1e-6f) * (seg == 0 ? 0.08838834764831845f : 1.0f);
#pragma unroll
            for (int c = 0; c < 8; ++c) o[c] *= rn;
            *(LAS u32x4*)(dst + (tg * 8 + t) * 136 + oc * 8) = pack8(o);
        }
    } else if (w == 6) {
        const float alog_e = __expf(p.in[I_GALOG][l * 4 + h]), dtb = p.in[I_GDTB][l * 4 + h];
        const int tp = tp0 + lane; const size_t row = brow + tp;
        float be = 0.f, g = 0.f;
        if (tp >= LEAD) { be = sigmoidf_(SM[row * 16 + h]); g = -alog_e * softplusf_(SM[row * 16 + 4 + h] + dtb); }
        g = wave_incl_scan(g, lane);
        gc[lane] = g; bt[lane] = be;
    }
    __syncthreads();
#pragma unroll 1
    for (int i = 0; i < 4; ++i) {
        const int t = w * 4 + i;
        const int tt = t & 15, ct = tt >> 2, st = tt & 3; const bool isK = t < 16;
        const int c = ct * 16 + fr, s0 = st * 16 + 4 * fq;
        f32x4 v = (f32x4){0.f, 0.f, 0.f, 0.f};
        if (st <= ct) v = mma_t<128>(isK ? Ks : Qs, 136, ct * 16, Ks, 136, st * 16, fr, fq, v);
        const float gcc = gc[c], bc = bt[c];
        f32x4 o;
#pragma unroll
        for (int j = 0; j < 4; ++j) { const int s = s0 + j; const bool keep = isK ? (s < c) : (s <= c); const float d = keep ? gcc - gc[s] : 0.f; const float val = keep ? v[j] * __expf(d) : 0.f; o[j] = isK ? val * bc : val; }
        if (isK) *(LAS f32x4*)(Lm + c * 68 + s0) = o; else *(LAS u32x2*)(As + c * 72 + s0) = pack4(o);
    }
    __syncthreads();
    if (w == 0) {
        float x[64];
        int lo_ = lane; asm volatile("" : "+v"(lo_));
        const float fl = (float)lo_;
        const LAS float* Lz = Lm + opaque_v0();
#pragma unroll
        for (int c = 0; c < 64; ++c) {
            float a = 0.f;
#pragma unroll
            for (int s4 = 0; s4 + 4 <= c; s4 += 4) { const f32x4 lv = *(const LAS f32x4*)(Lz + c * 68 + s4); a += lv[0] * x[s4]; a += lv[1] * x[s4 + 1]; a += lv[2] * x[s4 + 2]; a += lv[3] * x[s4 + 3]; if ((s4 & 12) == 12) asm volatile("" ::: "memory"); }
#pragma unroll
            for (int s = (c & ~3); s < c; ++s) a += Lz[c * 68 + s] * x[s];
            x[c] = fmaxf(0.f, 1.0f - fabsf(fl - (float)c)) - a;
            Tm[c * 72 + lane] = f2bf(x[c]);
            asm volatile("" ::: "memory");
        }
    }
    __syncthreads();
    { unsigned long long* ta = (unsigned long long*)(p.ws + WS_TA) + ((size_t)(bh * 33 + n)) * 2048;
#pragma unroll
      for (int i = 0; i < 4; ++i) { const int e8 = tid + i * NTHREADS, m = e8 >> 10, r = (e8 >> 4) & 63, c4 = (e8 & 15) * 4;
          const unsigned long long v = *(const LAS unsigned long long*)((m == 0 ? Tm : As) + r * 72 + c4);
          __hip_atomic_store(ta + e8, v, __ATOMIC_RELAXED, __HIP_MEMORY_SCOPE_AGENT); } }
    { unsigned long long* qk = (unsigned long long*)((bf16_t*)(p.ws + WS_XN) + (brow + tp0) * DM + h * 128);
#pragma unroll
      for (int i = 0; i < 8; ++i) { const int e8 = tid + i * NTHREADS, m = e8 >> 11, r = (e8 >> 5) & 63, c4 = (e8 & 31) * 4;
          const unsigned long long v = *(const LAS unsigned long long*)((m == 0 ? Qs : Ks) + r * 136 + c4);
          __hip_atomic_store(qk + ((size_t)r * DM + m * 512 + c4) / 4, v, __ATOMIC_RELAXED, __HIP_MEMORY_SCOPE_AGENT); } }
    asm volatile("s_waitcnt vmcnt(0)" ::: "memory");
    __syncthreads();
    if (tid == 0) __hip_atomic_store((unsigned*)(p.ws + WS_FLAG) + bh * 33 + n, (unsigned)(le + 1), __ATOMIC_RELAXED, __HIP_MEMORY_SCOPE_AGENT);
}
static __device__ __forceinline__ void gdn_helper_loop(const Params& p, int l, int le, LAS unsigned char* lds, int wv, int max_items = 1 << 30) {
    LAS unsigned* slot = (LAS unsigned*)(lds + 81920);
    unsigned* qhead = (unsigned*)(p.ws + WS_FLAG) + 1200 + le;
    for (;;) {
        const int tid = opaque_tid(wv);
        __syncthreads();
        if (tid == 0) slot[0] = __hip_atomic_fetch_add(qhead, 1u, __ATOMIC_RELAXED, __HIP_MEMORY_SCOPE_AGENT);
        __syncthreads();
        const unsigned item = slot[0];
        if (item >= 32u * 33u) break;
        gdn_produce(p, l, le, (int)(item & 31u), (int)(item >> 5), lds, wv);
        if (--max_items <= 0) { __syncthreads(); break; }
    }
}
static __device__ __forceinline__ void gdn_mixer(const Params& p, int l, int le, int b, int h, LAS unsigned char* lds, int wv) {
    LAS bf16_t* Qs = (LAS bf16_t*)(lds);
    LAS bf16_t* Ks = (LAS bf16_t*)(lds + 17408);
    LAS bf16_t* Vs = (LAS bf16_t*)(lds + 34816);
    LAS bf16_t* VT = Vs;
    LAS bf16_t* St = (LAS bf16_t*)(lds + 53248);
    LAS bf16_t* RT = (LAS bf16_t*)(lds + 88064);
    LAS bf16_t* As = (LAS bf16_t*)(lds + 106496);
    LAS bf16_t* Tm = (LAS bf16_t*)(lds + 115712);
    LAS float* Lm = (LAS float*)(lds + 124928);
    LAS bf16_t* KdT = (LAS bf16_t*)(lds + 124928);
    LAS float* gc = (LAS float*)(lds + 143360);
    LAS float* bt = gc + 64;
    LAS float* ssum = gc + 128;
    const bf16_t* PROJ = (const bf16_t*)(p.ws + WS_PROJ); const float* SM = (const float*)(p.ws + WS_SM); bf16_t* Y = (bf16_t*)(p.ws + WS_Y);
    const size_t brow = (size_t)b * TP;
    const float alog_e = __expf(p.in[I_GALOG][l * 4 + h]), dtb = p.in[I_GDTB][l * 4 + h];
    for (int i = opaque_tid(wv); i < 34816 / 4; i += NTHREADS) ((LAS unsigned*)St)[i] = 0u;
    f32x4 sacc[8];
#pragma unroll
    for (int i = 0; i < 8; ++i) sacc[i] = (f32x4){0.f, 0.f, 0.f, 0.f};
    __syncthreads();
    if (__builtin_amdgcn_readfirstlane(opaque_tid(wv) >> 6) == 1) { const unsigned* fl = (const unsigned*)(p.ws + WS_FLAG) + (b * 4 + h) * 33 + 0;
              unsigned spins = 0;
              while ((unsigned)__builtin_amdgcn_readfirstlane((int)__hip_atomic_load(fl, __ATOMIC_RELAXED, __HIP_MEMORY_SCOPE_AGENT)) != (unsigned)(le + 1)) { __builtin_amdgcn_s_sleep(2); if (++spins > (1u << 22)) break; }
              __builtin_amdgcn_fence(__ATOMIC_ACQUIRE, "agent");
              asm volatile("s_waitcnt vmcnt(0)" ::: "memory"); }
    __syncthreads();
    for (int n = 0; n < 33; ++n) {
        const int tp0 = n * 64;
        const int tid = opaque_tid(wv), lane = tid & 63, w = __builtin_amdgcn_readfirstlane(tid >> 6), fr = lane & 15, fq = lane >> 4;
        const int seg = tid >> 7, idx = tid & 127, tg = idx >> 4, oc = idx & 15, ct5 = w & 3, eh = w >> 2;
        const float* cwp0 = p.in[I_GCW] + (size_t)l * 4 * 1536 + (tid < 384 ? seg * 512 + h * 128 + oc * 8 : 0);
        if (tid < 256) {
            const bf16_t* QK = (const bf16_t*)(p.ws + WS_XN) + (brow + tp0) * DM + h * 128;
#pragma unroll
            for (int i = 0; i < 8; ++i) { const int e16 = tid + i * 256, m = e16 >> 10, r = (e16 >> 4) & 63, c8 = (e16 & 15) * 8;
                *(LAS u32x4*)((m == 0 ? Qs : Ks) + r * 136 + c8) = *(const u32x4*)(QK + (size_t)r * DM + m * 512 + c8); }
            if (w == 0) {
                const int tp = tp0 + lane; const size_t row = brow + tp;
                float be = 0.f, g = 0.f;
                if (tp >= LEAD) { be = sigmoidf_(SM[row * 16 + h]); g = -alog_e * softplusf_(SM[row * 16 + 4 + h] + dtb); }
                g = wave_incl_scan(g, lane);
                gc[lane] = g; bt[lane] = be;
            }
        } else {
            const int i2 = tid - 256, oc2 = i2 & 15, tg4 = i2 >> 4;
            const float* cwp = p.in[I_GCW] + (size_t)l * 4 * 1536 + 1024 + h * 128 + oc2 * 8; asm volatile("" : "+v"(cwp));
            float cw[4][8];
#pragma unroll
            for (int j = 0; j < 4; ++j) { const f32x4 a0 = *(const f32x4*)(cwp + j * 1536), a1 = *(const f32x4*)(cwp + j * 1536 + 4);
                cw[j][0] = a0[0]; cw[j][1] = a0[1]; cw[j][2] = a0[2]; cw[j][3] = a0[3]; cw[j][4] = a1[0]; cw[j][5] = a1[1]; cw[j][6] = a1[2]; cw[j][7] = a1[3]; }
            const bf16_t* colbase = PROJ + brow * PJ_LD + 2048 + h * 128 + oc2 * 8;
            u32x4 xr[7];
#pragma unroll
            for (int i = 0; i < 7; ++i) { const int tp = tp0 + tg4 * 4 - 3 + i; xr[i] = (tp >= 0) ? *(const u32x4*)(colbase + (size_t)tp * PJ_LD) : (u32x4){0u, 0u, 0u, 0u}; }
#pragma unroll
            for (int t = 0; t < 4; ++t) {
                float o[8];
#pragma unroll
                for (int c = 0; c < 8; ++c) o[c] = 0.f;
#pragma unroll
                for (int j = 0; j < 4; ++j) { float x[8]; unpack8(xr[t + j], x);
#pragma unroll
                    for (int c = 0; c < 8; ++c) o[c] += cw[j][c] * x[c]; }
#pragma unroll
                for (int c = 0; c < 8; ++c) o[c] = siluf_(o[c]);
                *(LAS u32x4*)(Vs + (tg4 * 4 + t) * 136 + oc2 * 8) = pack8(o);
            }
        }
        __syncthreads();
        const float gcl = gc[63];
        { const unsigned long long* ta = (const unsigned long long*)(p.ws + WS_TA) + ((size_t)((b * 4 + h) * 33 + n)) * 2048;
#pragma unroll
          for (int i = 0; i < 4; ++i) { const int e8 = tid + i * NTHREADS, m = e8 >> 10, r = (e8 >> 4) & 63, c4 = (e8 & 15) * 4;
              const unsigned long long v = ta[e8];
              *(LAS unsigned long long*)((m == 0 ? Tm : As) + r * 72 + c4) = v; } }
#pragma unroll 1
        for (int i = 0; i < 4; ++i) {
            const int tt = w * 4 + i, ct = tt >> 3, et = tt & 7;
            f32x4 v = mma_n<128>(Ks, 136, ct * 16, St, 136, et * 16, fr, fq, (f32x4){0.f, 0.f, 0.f, 0.f});
            const int e = et * 16 + fr, c0 = ct * 16 + 4 * fq;
            f32x4 r;
#pragma unroll
            for (int j = 0; j < 4; ++j) { const int c = c0 + j; r[j] = bt[c] * (bf2f(Vs[c * 136 + e]) - __expf(gc[c]) * v[j]); }
            *(LAS u32x2*)(RT + e * 72 + c0) = pack4(r);
        }
        __syncthreads();
#pragma unroll 1
        for (int i = 0; i < 4; ++i) { const int t = w * 4 + i, ct = t >> 3, et = t & 7;
            const f32x4 v = mma_n<64>(Tm, 72, ct * 16, RT, 72, et * 16, fr, fq, (f32x4){0.f, 0.f, 0.f, 0.f});
            *(LAS u32x2*)(VT + (et * 16 + fr) * 72 + ct * 16 + 4 * fq) = pack4(v); }
        { const int d = tid & 127, cg4 = tid >> 7;
#pragma unroll
            for (int i = 0; i < 16; ++i) { const int c = cg4 * 16 + i; KdT[d * 72 + c] = f2bf(bf2f(Ks[c * 136 + d]) * __expf(gcl - gc[c])); } }
        __syncthreads();
        if (w == 1 && n + 1 < 33) { const unsigned* fl = (const unsigned*)(p.ws + WS_FLAG) + (b * 4 + h) * 33 + (n + 1);
              unsigned spins = 0;
              while ((unsigned)__builtin_amdgcn_readfirstlane((int)__hip_atomic_load(fl, __ATOMIC_RELAXED, __HIP_MEMORY_SCOPE_AGENT)) != (unsigned)(le + 1)) { __builtin_amdgcn_s_sleep(2); if (++spins > (1u << 22)) break; }
              __builtin_amdgcn_fence(__ATOMIC_ACQUIRE, "agent");
              asm volatile("s_waitcnt vmcnt(0)" ::: "memory"); }
        const int c5 = ct5 * 16 + fr; const float egc = __expf(gc[c5]);
        f32x4 o[4]; float ssq = 0.f;
#pragma unroll
        for (int i = 0; i < 4; ++i) { const int et = eh * 4 + i;
            f32x4 v = mma_t<128>(Qs, 136, ct5 * 16, St, 136, et * 16, fr, fq, (f32x4){0.f, 0.f, 0.f, 0.f});
            v = v * egc;
            v = mma_t<64>(As, 72, ct5 * 16, VT, 72, et * 16, fr, fq, v);
            o[i] = v; ssq += v[0] * v[0] + v[1] * v[1] + v[2] * v[2] + v[3] * v[3]; }
        ssq += shx(ssq, 16, lane); ssq += shx(ssq, 32, lane);
        if (fq == 0) ssum[eh * 64 + c5] = ssq;
        const float last = __expf(gcl);
#pragma unroll
        for (int dt = 0; dt < 8; ++dt) { sacc[dt] = sacc[dt] * last; sacc[dt] = mma_t<64>(VT, 72, w * 16, KdT, 72, dt * 16, fr, fq, sacc[dt]); }
        __syncthreads();
        { const float tot = ssum[c5] + ssum[64 + c5]; const float rstd = rsqrtf(tot * (1.0f / 128.0f) + 1e-6f);
          const size_t row = brow + tp0 + c5;
#pragma unroll
          for (int i = 0; i < 4; ++i) { const int e0 = (eh * 4 + i) * 16 + 4 * fq;
              const u32x2 zz = *(const u32x2*)(PROJ + row * PJ_LD + 2560 + h * 128 + e0);
              const f32x4 g4 = *(const f32x4*)(p.in[I_GNORM] + l * 128 + e0);
              f32x4 y; y[0] = o[i][0] * rstd * g4[0] * siluf_(bflo(zz.x)); y[1] = o[i][1] * rstd * g4[1] * siluf_(bfhi(zz.x));
              y[2] = o[i][2] * rstd * g4[2] * siluf_(bflo(zz.y)); y[3] = o[i][3] * rstd * g4[3] * siluf_(bfhi(zz.y));
              *(u32x2*)(Y + row * DMIX + 512 + h * 128 + e0) = pack4(ymask_on(0) ? y : (f32x4){0.f, 0.f, 0.f, 0.f}); } }
#pragma unroll
        for (int dt = 0; dt < 8; ++dt) *(LAS u32x2*)(St + (w * 16 + fr) * 136 + dt * 16 + 4 * fq) = pack4(sacc[dt]);
    }
}

static __device__ __forceinline__ void ssd_mixer(const Params& p, int l, int b, int gi, int eh, LAS unsigned char* lds, int wv) {
    const int tid0 = opaque_tid(wv);
    LAS bf16_t* Cs = (LAS bf16_t*)(lds);
    LAS bf16_t* Bs = (LAS bf16_t*)(lds + 17408);
    LAS bf16_t* BsT = (LAS bf16_t*)(lds + 34816);
    LAS bf16_t* Xs = (LAS bf16_t*)(lds + 53248);
    LAS float* CBf = (LAS float*)(lds + 87040);
    LAS bf16_t* Ms = (LAS bf16_t*)(lds + 104448);
    LAS bf16_t* XsT = (LAS bf16_t*)(lds + 113664);
    LAS bf16_t* XdT = (LAS bf16_t*)(lds + 122880);
    LAS bf16_t* Sb = (LAS bf16_t*)(lds + 132096);
    LAS float* dtl = (LAS float*)(lds + 149504);
    LAS float* acm = dtl + 256;
    const bf16_t* PROJ = (const bf16_t*)(p.ws + WS_PROJ); const float* SM = (const float*)(p.ws + WS_SM); bf16_t* Y = (bf16_t*)(p.ws + WS_Y);
    const size_t brow = (size_t)b * TP;
    const int w0 = __builtin_amdgcn_readfirstlane(tid0 >> 6);
    const float nalog = -__expf(p.in[I_SALOG][l * 8 + gi * 4 + (w0 & 3)]), dtb = p.in[I_SDTB][l * 8 + gi * 4 + (w0 & 3)];
    f32x4 sacc[4];
#pragma unroll
    for (int i = 0; i < 4; ++i) sacc[i] = (f32x4){0.f, 0.f, 0.f, 0.f};
    for (int n = 0; n < 33; ++n) {
        const int tp0 = n * 64;
        const int tid = opaque_tid(wv);
        const int lane = tid & 63, w = __builtin_amdgcn_readfirstlane(tid >> 6), fr = lane & 15, fq = lane >> 4;
        const int oc = lane, tg = w;
        const int xi = oc < 32 ? gi * 256 + oc * 8 : (oc < 48 ? 512 + gi * 128 + (oc - 32) * 8 : 768 + gi * 128 + (oc - 48) * 8);
        const int hh_w = gi * 4 + (w & 3);
        const int lt = w & 3, ph = w >> 2;
        const float* cwp0 = p.in[I_SCW] + (size_t)l * 4 * 1024 + xi; const float* cbp0 = p.in[I_SCB] + (size_t)l * 1024 + xi;
        {
            const bf16_t* colbase = PROJ + brow * PJ_LD + 3584 + xi;
            float cw[4][8], cb[8];
            { const float* cwp = cwp0; const float* cbp = cbp0; asm volatile("" : "+v"(cwp), "+v"(cbp));
              { const f32x4 a0 = *(const f32x4*)(cbp), a1 = *(const f32x4*)(cbp + 4); cb[0] = a0[0]; cb[1] = a0[1]; cb[2] = a0[2]; cb[3] = a0[3]; cb[4] = a1[0]; cb[5] = a1[1]; cb[6] = a1[2]; cb[7] = a1[3]; }
#pragma unroll
              for (int j = 0; j < 4; ++j) { const f32x4 a0 = *(const f32x4*)(cwp + j * 1024), a1 = *(const f32x4*)(cwp + j * 1024 + 4);
                  cw[j][0] = a0[0]; cw[j][1] = a0[1]; cw[j][2] = a0[2]; cw[j][3] = a0[3]; cw[j][4] = a1[0]; cw[j][5] = a1[1]; cw[j][6] = a1[2]; cw[j][7] = a1[3]; } }
            u32x4 xr[11];
#pragma unroll
            for (int i = 0; i < 11; ++i) { const int tp = tp0 + tg * 8 - 3 + i; xr[i] = (tp >= 0) ? *(const u32x4*)(colbase + (size_t)tp * PJ_LD) : (u32x4){0u, 0u, 0u, 0u}; }
#pragma unroll
            for (int t = 0; t < 8; ++t) {
                const int tt = tg * 8 + t; const bool valid = (tp0 + tt) >= LEAD;
                float o[8];
#pragma unroll
                for (int c = 0; c < 8; ++c) o[c] = cb[c];
#pragma unroll
                for (int j = 0; j < 4; ++j) { float x[8]; unpack8(xr[t + j], x);
#pragma unroll
                    for (int c = 0; c < 8; ++c) o[c] += cw[j][c] * x[c]; }
#pragma unroll
                for (int c = 0; c < 8; ++c) o[c] = valid ? siluf_(o[c]) : 0.f;
                const u32x4 pk = pack8(o);
                if (oc < 32) *(LAS u32x4*)(Xs + tt * 264 + oc * 8) = pk;
                else if (oc < 48) { *(LAS u32x4*)(Bs + tt * 136 + (oc - 32) * 8) = pk;
#pragma unroll
                    for (int c = 0; c < 8; ++c) BsT[((oc - 32) * 8 + c) * 72 + tt] = f2bf(o[c]); }
                else *(LAS u32x4*)(Cs + tt * 136 + (oc - 48) * 8) = pk;
            }
            if (w < 4) {
                const int tp = tp0 + lane; const size_t row = brow + tp;
                float dt = 0.f;
                if (tp >= LEAD) dt = softplusf_(SM[row * 16 + 8 + hh_w] + dtb);
                const float a = wave_incl_scan(nalog * dt, lane);
                dtl[w * 64 + lane] = dt; acm[w * 64 + lane] = a;
            }
        }
        __syncthreads();
#pragma unroll 1
        for (int i = 0; i < 2; ++i) { const int t = w * 2 + i, ltt = t >> 2, st = t & 3;
            f32x4 v = (f32x4){0.f, 0.f, 0.f, 0.f};
            if (st <= ltt) v = mma_t<128>(Cs, 136, ltt * 16, Bs, 136, st * 16, fr, fq, v);
            *(LAS f32x4*)(CBf + (ltt * 16 + fr) * 68 + st * 16 + 4 * fq) = v; }
        __syncthreads();
        f32x4 yv[2];
        { const int e = eh;
            const float alast = acm[e * 64 + 63];
#pragma unroll
            for (int i = 0; i < 4; ++i) { const f32x4 sv = sacc[i];
                *(LAS u32x2*)(Sb + (lt * 16 + fr) * 136 + (ph * 4 + i) * 16 + 4 * fq) = pack4(sv); }
            { const int ll = tid >> 3, s0 = (tid & 7) * 8; const float al = acm[e * 64 + ll];
              float m[8];
#pragma unroll
              for (int j = 0; j < 8; ++j) { const int s = s0 + j; const bool keep = s <= ll; const float d = keep ? al - acm[e * 64 + s] : 0.f; m[j] = keep ? CBf[ll * 68 + s] * __expf(d) * dtl[e * 64 + s] : 0.f; }
              *(LAS u32x4*)(Ms + ll * 72 + s0) = pack8(m); }
            { const int pp = tid & 63, lg = tid >> 6;
              float xs8[8], xd8[8];
#pragma unroll
              for (int i = 0; i < 8; ++i) { const int ll = lg * 8 + i; const float x = bf2f(Xs[ll * 264 + e * 64 + pp]); xs8[i] = x; xd8[i] = x * __expf(alast - acm[e * 64 + ll]) * dtl[e * 64 + ll]; }
              *(LAS u32x4*)(XsT + pp * 72 + lg * 8) = pack8(xs8); *(LAS u32x4*)(XdT + pp * 72 + lg * 8) = pack8(xd8); }
            __syncthreads();
            const float eal = __expf(acm[e * 64 + lt * 16 + fr]);
            const float dsk = p.in[I_SD][l * 8 + gi * 4 + e];
#pragma unroll
            for (int i = 0; i < 2; ++i) { const int pt = ph * 2 + i;
                f32x4 v = mma_t<128>(Cs, 136, lt * 16, Sb, 136, pt * 16, fr, fq, (f32x4){0.f, 0.f, 0.f, 0.f});
                v = v * eal;
                v = mma_t<64>(Ms, 72, lt * 16, XsT, 72, pt * 16, fr, fq, v);
                const u32x2 xx = *(const LAS u32x2*)(Xs + (lt * 16 + fr) * 264 + e * 64 + pt * 16 + 4 * fq);
                v[0] += dsk * bflo(xx.x); v[1] += dsk * bfhi(xx.x); v[2] += dsk * bflo(xx.y); v[3] += dsk * bfhi(xx.y);
                yv[i] = v; }
            const float dec = __expf(alast);
#pragma unroll
            for (int i = 0; i < 4; ++i) {
                f32x4 sv = sacc[i] * dec;
                sv = mma_t<64>(XdT, 72, lt * 16, BsT, 72, (ph * 4 + i) * 16, fr, fq, sv);
                sacc[i] = sv; }
            __syncthreads();
        }
        const size_t row = brow + tp0 + lt * 16 + fr;
        float ssq = 0.f;
#pragma unroll
        for (int i = 0; i < 2; ++i) { const int ch = eh * 64 + (ph * 2 + i) * 16 + 4 * fq;
            const u32x2 zz = *(const u32x2*)(PROJ + row * PJ_LD + 3072 + gi * 256 + ch);
            f32x4 v = yv[i];
            v[0] *= siluf_(bflo(zz.x)); v[1] *= siluf_(bfhi(zz.x)); v[2] *= siluf_(bflo(zz.y)); v[3] *= siluf_(bfhi(zz.y));
            ssq += v[0] * v[0] + v[1] * v[1] + v[2] * v[2] + v[3] * v[3];
            *(u32x2*)(Y + row * DMIX + 1024 + gi * 256 + ch) = pack4(v); }
        ssq += shx(ssq, 16, lane); ssq += shx(ssq, 32, lane);
        if (fq == 0) ((float*)(p.ws + WS_SSQ))[row * 16 + gi * 8 + eh * 2 + ph] = ssq;
    }
}

static __device__ __forceinline__ void lru_mixer(const Params& p, int l, int b, int sg, LAS unsigned char* lds, int wv) {
    const int tid = opaque_tid(wv), lane = tid & 63, w = __builtin_amdgcn_readfirstlane(tid >> 6), fr = lane & 15, fq = lane >> 4;
    LAS float* xcs = (LAS float*)(lds + w * 17408);
    LAS float* gts = xcs + 32 * 68;
    bf16_t* PROJ = (bf16_t*)(p.ws + WS_PROJ); bf16_t* Y = (bf16_t*)(p.ws + WS_Y);
    const size_t brow = (size_t)b * TP;
    bf16x8 wa[4][2], wi[4][2];
    { const float* wap = p.in[I_LWA] + (size_t)(l * 8 + w) * 4096; const float* wip = p.in[I_LWI] + (size_t)(l * 8 + w) * 4096;
#pragma unroll
      for (int nt = 0; nt < 4; ++nt)
#pragma unroll
          for (int ks = 0; ks < 2; ++ks) { float a8[8], i8[8];
#pragma unroll
              for (int jj = 0; jj < 8; ++jj) { const int i = ks * 32 + fq * 8 + jj, j = nt * 16 + fr; a8[jj] = wap[i * 64 + j]; i8[jj] = wip[i * 64 + j]; }
              const u32x4 pa = pack8(a8), pi = pack8(i8); wa[nt][ks] = *(const bf16x8*)&pa; wi[nt][ks] = *(const bf16x8*)&pi; } }
    float ba[4], bi[4], sp8[4];
#pragma unroll
    for (int nt = 0; nt < 4; ++nt) { const int ch = l * 512 + w * 64 + nt * 16 + fr; ba[nt] = p.in[I_LBA][ch]; bi[nt] = p.in[I_LBI][ch]; sp8[nt] = 8.0f * softplusf_(-p.in[I_LLAM][ch]); }
    float hc[4] = {0.f, 0.f, 0.f, 0.f}, pc[4] = {1.f, 1.f, 1.f, 1.f};
    for (int hk = sg * LRU_HK; hk < (sg + 1) * LRU_HK; ++hk) {
        const int tp0 = hk * 32;
        const int tidv = opaque_tid(wv);
        const int lane = tidv & 63, fr = lane & 15, fq = lane >> 4, oc = lane & 7, tgp = lane >> 3;
        const float* cwp0 = p.in[I_LCW] + (size_t)l * 4 * 512 + w * 64 + oc * 8; const float* cbp0 = p.in[I_LCB] + (size_t)l * 512 + w * 64 + oc * 8;
        {
            const bf16_t* colx = PROJ + brow * PJ_LD + w * 64 + oc * 8;
            float cw[4][8], cb[8];
            { const float* cwp = cwp0; const float* cbp = cbp0; asm volatile("" : "+v"(cwp), "+v"(cbp));
              { const f32x4 a0 = *(const f32x4*)(cbp), a1 = *(const f32x4*)(cbp + 4); cb[0] = a0[0]; cb[1] = a0[1]; cb[2] = a0[2]; cb[3] = a0[3]; cb[4] = a1[0]; cb[5] = a1[1]; cb[6] = a1[2]; cb[7] = a1[3]; }
#pragma unroll
              for (int j = 0; j < 4; ++j) { const f32x4 a0 = *(const f32x4*)(cwp + j * 512), a1 = *(const f32x4*)(cwp + j * 512 + 4);
                  cw[j][0] = a0[0]; cw[j][1] = a0[1]; cw[j][2] = a0[2]; cw[j][3] = a0[3]; cw[j][4] = a1[0]; cw[j][5] = a1[1]; cw[j][6] = a1[2]; cw[j][7] = a1[3]; } }
            u32x4 xr[7];
#pragma unroll
            for (int i = 0; i < 7; ++i) { const int tp = tp0 + tgp * 4 - 3 + i; xr[i] = (tp >= 0) ? *(const u32x4*)(colx + (size_t)tp * PJ_LD) : (u32x4){0u, 0u, 0u, 0u}; }
#pragma unroll
            for (int t = 0; t < 4; ++t) {
                const int tt = tgp * 4 + t;
                float o[8];
#pragma unroll
                for (int c = 0; c < 8; ++c) o[c] = cb[c];
#pragma unroll
                for (int j = 0; j < 4; ++j) { float x[8]; unpack8(xr[t + j], x);
#pragma unroll
                    for (int c = 0; c < 8; ++c) o[c] += cw[j][c] * x[c]; }
                *(LAS f32x4*)(xcs + tt * 68 + oc * 8) = (f32x4){o[0], o[1], o[2], o[3]}; *(LAS f32x4*)(xcs + tt * 68 + oc * 8 + 4) = (f32x4){o[4], o[5], o[6], o[7]};
                const u32x4 gr = *(const u32x4*)(colx + 512 + (size_t)(tp0 + tt) * PJ_LD);
                float gg[8]; unpack8(gr, gg);
#pragma unroll
                for (int c = 0; c < 8; ++c) gg[c] = gelu_tanh(gg[c]);
                *(LAS f32x4*)(gts + tt * 68 + oc * 8) = (f32x4){gg[0], gg[1], gg[2], gg[3]}; *(LAS f32x4*)(gts + tt * 68 + oc * 8 + 4) = (f32x4){gg[4], gg[5], gg[6], gg[7]};
                __builtin_amdgcn_sched_barrier(0);
            }
        }
        lds_wave_sync();
#pragma unroll
        for (int q = 0; q < 2; ++q) {
            bf16x8 afr[2];
#pragma unroll
            for (int ks = 0; ks < 2; ++ks) { const f32x4 x0 = *(const LAS f32x4*)(xcs + (q * 16 + fr) * 68 + ks * 32 + fq * 8), x1 = *(const LAS f32x4*)(xcs + (q * 16 + fr) * 68 + ks * 32 + fq * 8 + 4);
                u32x4 pk; pk.x = cvt_pk_bf16(x0[0], x0[1]); pk.y = cvt_pk_bf16(x0[2], x0[3]); pk.z = cvt_pk_bf16(x1[0], x1[1]); pk.w = cvt_pk_bf16(x1[2], x1[3]); afr[ks] = *(const bf16x8*)&pk; }
#pragma unroll
            for (int nt = 0; nt < 4; ++nt) {
                f32x4 ar = (f32x4){0.f, 0.f, 0.f, 0.f}, ai = (f32x4){0.f, 0.f, 0.f, 0.f};
                ar = mfma16(afr[0], wa[nt][0], ar); ar = mfma16(afr[1], wa[nt][1], ar);
                ai = mfma16(afr[0], wi[nt][0], ai); ai = mfma16(afr[1], wi[nt][1], ai);
                float a[4], bb[4];
#pragma unroll
                for (int j = 0; j < 4; ++j) { const int tok = q * 16 + 4 * fq + j; const bool valid = (tp0 + tok) >= LEAD;
                    const float r = sigmoidf_(ar[j] + ba[nt]), ig = sigmoidf_(ai[j] + bi[nt]); const float la = -sp8[nt] * r;
                    const float xc = xcs[tok * 68 + nt * 16 + fr];
                    a[j] = valid ? __expf(la) : 1.0f; bb[j] = valid ? sqrtf(neg_expm1(2.0f * la)) * ig * xc : 0.f; }
                const float A4 = a[0] * a[1] * a[2] * a[3], B4 = ((bb[0] * a[1] + bb[1]) * a[2] + bb[2]) * a[3] + bb[3];
                float hprev = hc[nt], hin = hc[nt], pprev = pc[nt], pin = pc[nt];
#pragma unroll
                for (int qq = 0; qq < 4; ++qq) { const float Aq = shidx(A4, fr + 16 * qq), Bq = shidx(B4, fr + 16 * qq); const float hn = Aq * hprev + Bq, pn = Aq * pprev; if (qq + 1 == fq) { hin = hn; pin = pn; } hprev = hn; pprev = pn; }
                hc[nt] = hprev; pc[nt] = pprev;
                float hcur = hin, pcur = pin;
#pragma unroll
                for (int j = 0; j < 4; ++j) { const int tok = q * 16 + 4 * fq + j; hcur = a[j] * hcur + bb[j]; pcur = a[j] * pcur; const float gt = gts[tok * 68 + nt * 16 + fr];
                    const size_t row = brow + tp0 + tok;
                    Y[row * DMIX + w * 64 + nt * 16 + fr] = f2bf(gt * hcur);
                    PROJ[row * PJ_LD + 512 + w * 64 + nt * 16 + fr] = f2bf(gt * pcur); }
                __builtin_amdgcn_sched_barrier(0);
            }
        }
    }
    { float* CAR = (float*)(p.ws + WS_CAR) + ((size_t)(b * LRU_SEG + sg) * 2) * WG + w * 64;
      if (fq == 0) {
#pragma unroll
          for (int nt = 0; nt < 4; ++nt) { CAR[nt * 16 + fr] = hc[nt]; CAR[WG + nt * 16 + fr] = pc[nt]; } } }
}

static __device__ __forceinline__ void lru_fix_tile(const Params& p, int l, LAS unsigned char* lds, int tile, int wv) {
    const int tid = opaque_tid(wv), lane = tid & 63, w = __builtin_amdgcn_readfirstlane(tid >> 6);
    const int b = tile / 33, t = tile % 33, sg = t / 3;
    LAS float* hin = (LAS float*)(lds + 69632);
    const float* CAR = (const float*)(p.ws + WS_CAR) + (size_t)(b * LRU_SEG) * 2 * WG;
    { float ce[LRU_SEG - 1], cp[LRU_SEG - 1];
#pragma unroll
      for (int s = 0; s < LRU_SEG - 1; ++s) { const bool on = s < sg; ce[s] = on ? CAR[(size_t)s * 2 * WG + tid] : 0.f; cp[s] = on ? CAR[(size_t)s * 2 * WG + WG + tid] : 1.f; }
      float h = 0.f;
#pragma unroll
      for (int s = 0; s < LRU_SEG - 1; ++s) h = (s < sg) ? cp[s] * h + ce[s] : h;
      hin[tid] = h; }
    __syncthreads();
    bf16_t* Y = (bf16_t*)(p.ws + WS_Y); const bf16_t* PROJ = (const bf16_t*)(p.ws + WS_PROJ);
    float hv[8], gv[8];
#pragma unroll
    for (int c = 0; c < 8; ++c) { hv[c] = hin[lane * 8 + c]; gv[c] = p.in[I_LNORM][l * 512 + lane * 8 + c]; }
#pragma unroll 1
    for (int i0 = 0; i0 < 8; i0 += 4) {
        u32x4 a1[4], a2[4];
#pragma unroll
        for (int k = 0; k < 4; ++k) { const size_t row = (size_t)tile * 64 + w + 8 * (i0 + k); a1[k] = *(const u32x4*)(Y + row * DMIX + lane * 8); a2[k] = *(const u32x4*)(PROJ + row * PJ_LD + 512 + lane * 8); }
#pragma unroll
        for (int k = 0; k < 4; ++k) { const size_t row = (size_t)tile * 64 + w + 8 * (i0 + k);
            float y1[8], y2[8]; unpack8(a1[k], y1); unpack8(a2[k], y2);
            float ss = 0.f;
#pragma unroll
            for (int c = 0; c < 8; ++c) { y1[c] += y2[c] * hv[c]; ss += y1[c] * y1[c]; }
#pragma unroll
            for (int o = 32; o >= 1; o >>= 1) ss += shx(ss, o, lane);
            const float rstd = rsqrtf(ss * (1.0f / 512.0f) + 1e-6f);
#pragma unroll
            for (int c = 0; c < 8; ++c) y1[c] *= rstd * gv[c];
            *(u32x4*)(Y + row * DMIX + lane * 8) = pack8(y1); }
    }
    __syncthreads();
}
static __device__ __forceinline__ void ssd_norm_tile(const Params& p, int l, int tile, int wv) {
    const int tid = opaque_tid(wv), lane = tid & 63, w = __builtin_amdgcn_readfirstlane(tid >> 6);
    bf16_t* Y = (bf16_t*)(p.ws + WS_Y);
    float sgv[8];
#pragma unroll
    for (int c = 0; c < 8; ++c) sgv[c] = p.in[I_SNORM][l * 512 + lane * 8 + c];
#pragma unroll 1
    for (int i0 = 0; i0 < 8; i0 += 4) {
        u32x4 yy[4]; f32x4 q0[4], q1[4];
#pragma unroll
        for (int k = 0; k < 4; ++k) { const size_t row = (size_t)tile * 64 + w + 8 * (i0 + k); const float* sq = (const float*)(p.ws + WS_SSQ) + row * 16 + (lane >> 5) * 8;
            yy[k] = *(const u32x4*)(Y + row * DMIX + 1024 + lane * 8); q0[k] = *(const f32x4*)sq; q1[k] = *(const f32x4*)(sq + 4); }
#pragma unroll
        for (int k = 0; k < 4; ++k) { const size_t row = (size_t)tile * 64 + w + 8 * (i0 + k);
            const float rs = rsqrtf(((q0[k][0] + q0[k][1]) + (q0[k][2] + q0[k][3]) + (q1[k][0] + q1[k][1]) + (q1[k][2] + q1[k][3])) * (1.0f / 256.0f) + 1e-6f);
            float yc[8]; unpack8(yy[k], yc);
#pragma unroll
            for (int c = 0; c < 8; ++c) yc[c] *= rs * sgv[c];
            *(u32x4*)(Y + row * DMIX + 1024 + lane * 8) = pack8(yc); }
    }
}

static __device__ __forceinline__ void s5_scan(const Params& p, int l, int b, int qd, LAS unsigned char* lds, int wv) {
    const int tid = opaque_tid(wv), lane = tid & 63, w = __builtin_amdgcn_readfirstlane(tid >> 6), fr = lane & 15, fq = lane >> 4;
    const int g = qd * 8 + w, lg = l * 32 + g;
    LAS float* bu = (LAS float*)(lds + w * 12800);
    LAS bf16_t* sb = (LAS bf16_t*)(lds + w * 12800 + 8448);
    const bf16_t* PROJ = (const bf16_t*)(p.ws + WS_PROJ); bf16_t* YP = (bf16_t*)(p.ws + WS_YP);
    const size_t brow = (size_t)b * TP;
    const float dt = __expf(p.in[I_5LDT][lg]);
    float ab_re, ab_im;
    { const float lre = fminf(p.in[I_5ARE][lg * 64 + lane], -1e-4f), lim = p.in[I_5AIM][lg * 64 + lane]; const float mag = expf(dt * lre); ab_re = mag * cosf(dt * lim); ab_im = mag * sinf(dt * lim); }
    bf16x8 bbfr[8];
#pragma unroll
    for (int pt = 0; pt < 8; ++pt) { const int pp = pt * 16 + fr, ps = pp & 63; const bool isim = pp >= 64;
        const float lre = fminf(p.in[I_5ARE][lg * 64 + ps], -1e-4f), lim = p.in[I_5AIM][lg * 64 + ps]; const float mag = expf(dt * lre), are = mag * cosf(dt * lim), aim = mag * sinf(dt * lim);
        const float den = lre * lre + lim * lim; const float fre = ((are - 1.0f) * lre + aim * lim) / den, fim = (aim * lre - (are - 1.0f) * lim) / den;
        const float* brp = p.in[I_5BRE] + ((size_t)lg * 64 + ps) * 16 + (fq & 1) * 8; const float* bip = p.in[I_5BIM] + ((size_t)lg * 64 + ps) * 16 + (fq & 1) * 8;
        float v8[8];
#pragma unroll
        for (int jj = 0; jj < 8; ++jj) { const float br = brp[jj], bi = bip[jj]; const float bb = isim ? (fre * bi + fim * br) : (fre * br - fim * bi);
            const float hi = bf2f(f2bf(bb)); v8[jj] = (fq < 2) ? hi : (bb - hi); }
        const u32x4 pk = pack8(v8); bbfr[pt] = *(const bf16x8*)&pk; }
    bf16x8 cfr[4];
#pragma unroll
    for (int ks = 0; ks < 4; ++ks) { float v8[8];
#pragma unroll
        for (int jj = 0; jj < 8; ++jj) { const int k = ks * 32 + fq * 8 + jj; v8[jj] = k < 64 ? p.in[I_5CRE][((size_t)lg * 16 + fr) * 64 + k] : -p.in[I_5CIM][((size_t)lg * 16 + fr) * 64 + k - 64]; }
        const u32x4 pk = pack8(v8); cfr[ks] = *(const bf16x8*)&pk; }
    const float dsk = p.in[I_5D][l * 512 + g * 16 + fr];
    float s_re = 0.f, s_im = 0.f;
    u32x4 uvn = *(const u32x4*)(PROJ + (brow + fr) * PJ_LD + 4608 + g * 16 + (fq & 1) * 8);
#pragma unroll 1
    for (int st = 0; st < 132; ++st) {
        const size_t row0 = brow + st * 16;
        const u32x4 uv = uvn;
        if (st + 1 < 132) uvn = *(const u32x4*)(PROJ + (row0 + 16 + fr) * PJ_LD + 4608 + g * 16 + (fq & 1) * 8);
        const bf16x8 ufr = *(const bf16x8*)&uv;
#pragma unroll
        for (int pt = 0; pt < 8; ++pt) { const f32x4 acc = mfma16(ufr, bbfr[pt], (f32x4){0.f, 0.f, 0.f, 0.f});
#pragma unroll
            for (int j = 0; j < 4; ++j) bu[(4 * fq + j) * 132 + pt * 16 + fr] = acc[j]; }
        lds_wave_sync();
#pragma unroll
        for (int t = 0; t < 16; ++t) { const float bre = bu[t * 132 + lane], bim = bu[t * 132 + 64 + lane];
            const float nre = ab_re * s_re - ab_im * s_im + bre, nim = ab_re * s_im + ab_im * s_re + bim; s_re = nre; s_im = nim;
            sb[t * 136 + lane] = f2bf(s_re); sb[t * 136 + 64 + lane] = f2bf(s_im); }
        lds_wave_sync();
        f32x4 acc = (f32x4){0.f, 0.f, 0.f, 0.f};
#pragma unroll
        for (int ks = 0; ks < 4; ++ks) acc = mfma16(ldsfrag(sb, 136, fr, ks * 32 + fq * 8), cfr[ks], acc);
#pragma unroll
        for (int j = 0; j < 4; ++j) { const size_t row = row0 + 4 * fq + j; const float u = bf2f(PROJ[row * PJ_LD + 4608 + g * 16 + fr]);
            YP[row * 512 + g * 16 + fr] = f2bf(gelu_tanh(acc[j] + dsk * u)); }
        lds_wave_sync();
    }
}

static __device__ __forceinline__ void s5_glu_tile(const Params& p, int l, LAS unsigned char* lds, int tile, int wv) {
    const int tid = opaque_tid(wv), lane = tid & 63, w = __builtin_amdgcn_readfirstlane(tid >> 6), fr = lane & 15, fq = lane >> 4;
    LAS bf16_t* At = (LAS bf16_t*)lds;
    LAS float* ssum = (LAS float*)(lds + 66560);
    const bf16_t* YP = (const bf16_t*)(p.ws + WS_YP); bf16_t* Y = (bf16_t*)(p.ws + WS_Y); const bf16_t* Wg = (const bf16_t*)(p.ws + WS_W) + W_GLU;
    {
        const size_t row0 = (size_t)tile * 64;
#pragma unroll
        for (int i = 0; i < 8; ++i) { const int e = tid + i * NTHREADS, r = e >> 6, c8 = (e & 63) * 8; *(LAS u32x4*)(At + r * 520 + c8) = *(const u32x4*)(YP + (row0 + r) * 512 + c8); }
        __syncthreads();
        f32x4 acc[4][4];
#pragma unroll
        for (int a = 0; a < 4; ++a)
#pragma unroll
            for (int c = 0; c < 4; ++c) acc[a][c] = (f32x4){0.f, 0.f, 0.f, 0.f};
#pragma unroll 2
        for (int ks = 0; ks < 16; ++ks) {
            bf16x8 bfr[4];
#pragma unroll
            for (int nt = 0; nt < 4; ++nt) bfr[nt] = *(const bf16x8*)(Wg + (size_t)(w * 64 + nt * 16 + fr) * 512 + ks * 32 + fq * 8);
#pragma unroll
            for (int tt = 0; tt < 4; ++tt) { const bf16x8 afr = ldsfrag(At, 520, tt * 16 + fr, ks * 32 + fq * 8);
#pragma unroll
                for (int nt = 0; nt < 4; ++nt) acc[tt][nt] = mfma16(bfr[nt], afr, acc[tt][nt]); }
        }
#pragma unroll
        for (int tt = 0; tt < 4; ++tt) { float ssq = 0.f;
#pragma unroll
            for (int nt = 0; nt < 4; ++nt) { const u32x2 yy = *(const LAS u32x2*)(At + (tt * 16 + fr) * 520 + w * 64 + nt * 16 + 4 * fq);
                f32x4 v; v[0] = bflo(yy.x) * sigmoidf_(acc[tt][nt][0]); v[1] = bfhi(yy.x) * sigmoidf_(acc[tt][nt][1]); v[2] = bflo(yy.y) * sigmoidf_(acc[tt][nt][2]); v[3] = bfhi(yy.y) * sigmoidf_(acc[tt][nt][3]);
                acc[tt][nt] = v; ssq += v[0] * v[0] + v[1] * v[1] + v[2] * v[2] + v[3] * v[3]; }
            ssq += shx(ssq, 16, lane); ssq += shx(ssq, 32, lane);
            if (fq == 0) ssum[w * 64 + tt * 16 + fr] = ssq; }
        __syncthreads();
#pragma unroll
        for (int tt = 0; tt < 4; ++tt) { const int t = tt * 16 + fr; float tot = 0.f;
#pragma unroll
            for (int ww = 0; ww < 8; ++ww) tot += ssum[ww * 64 + t];
            const float rstd = rsqrtf(tot * (1.0f / 512.0f) + 1e-6f);
#pragma unroll
            for (int nt = 0; nt < 4; ++nt) { const int n0 = w * 64 + nt * 16 + 4 * fq; const f32x4 g4 = *(const f32x4*)(p.in[I_5NORM] + l * 512 + n0);
                *(u32x2*)(Y + (row0 + t) * DMIX + 1536 + n0) = pack4(ymask_on(3) ? acc[tt][nt] * rstd * g4 : (f32x4){0.f, 0.f, 0.f, 0.f}); } }
        __syncthreads();
    }
}

static __device__ __forceinline__ void zero_y_cols(const Params& p, int b, int c0, int ncols, int part, int nparts, int wv) {
    const int tid = opaque_tid(wv); bf16_t* Y = (bf16_t*)(p.ws + WS_Y);
    (void)part; (void)nparts;
#pragma unroll 1
    for (int r = tid >> 6; r < TP; r += NTHREADS / 64)
#pragma unroll 1
        for (int c = (tid & 63) * 8; c < ncols; c += 512) *(u32x4*)(Y + ((size_t)b * TP + r) * DMIX + c0 + c) = (u32x4){0u, 0u, 0u, 0u};
}
static __device__ __forceinline__ void finalize_loop(const Params& p, int l, int le, LAS unsigned char* lds, int wv) {
    LAS unsigned* slot = (LAS unsigned*)(lds + 81920);
    for (int type = 0; type < 2; ++type) {
        unsigned* qhead = (unsigned*)(p.ws + WS_FLAG) + 1216 + type * 8 + le;
        const unsigned* done = (const unsigned*)(p.ws + WS_FLAG) + 1232 + type * 64 + le * 8;
        const unsigned need = type == 0 ? 15u : 8u;
        for (;;) {
            const int tid = opaque_tid(wv);
            __syncthreads();
            if (tid == 0) slot[0] = __hip_atomic_fetch_add(qhead, 1u, __ATOMIC_RELAXED, __HIP_MEMORY_SCOPE_AGENT);
            __syncthreads();
            const unsigned item = slot[0];
            if (item >= (unsigned)(MP / 64)) break;
            if (tid < 64) {
                unsigned spins = 0;
                while ((unsigned)__builtin_amdgcn_readfirstlane((int)__hip_atomic_load(done + item / 33u, __ATOMIC_RELAXED, __HIP_MEMORY_SCOPE_AGENT)) < need) { __builtin_amdgcn_s_sleep(4); if (++spins > (1u << 22)) break; }
                __builtin_amdgcn_fence(__ATOMIC_ACQUIRE, "agent");
                asm volatile("s_waitcnt vmcnt(0)" ::: "memory");
            }
            __syncthreads();
            if (type == 0) { s5_glu_tile(p, l, lds, (int)item, wv); lru_fix_tile(p, l, lds, (int)item, wv); }
            else ssd_norm_tile(p, l, (int)item, wv);
        }
    }
}
static __device__ __forceinline__ void role_done(const Params& p, int le, int b, int type, int wv) {
    __threadfence();
    asm volatile("s_waitcnt vmcnt(0)" ::: "memory");
    __syncthreads();
    if (opaque_tid(wv) == 0) __hip_atomic_fetch_add((unsigned*)(p.ws + WS_FLAG) + 1232 + type * 64 + le * 8 + b, 1u, __ATOMIC_RELAXED, __HIP_MEMORY_SCOPE_AGENT);
}

static __device__ __forceinline__ void mixer_phase(const Params& p, int l, int le, LAS unsigned char* lds, int bid, int wv) {
    if (bid < 32) { gdn_mixer(p, l, le, bid >> 2, bid & 3, lds, wv); return; }
    if (bid < 96) { const int j = bid - 32; ssd_mixer(p, l, j >> 3, (j >> 2) & 1, j & 3, lds, wv); role_done(p, le, j >> 3, 1, wv); }
    else if (bid < 96 + NB * LRU_SEG) { gdn_helper_loop(p, l, le, lds, wv, 2);
        lru_mixer(p, l, (bid - 96) / LRU_SEG, (bid - 96) % LRU_SEG, lds, wv); role_done(p, le, (bid - 96) / LRU_SEG, 0, wv); }
    else if (bid < 96 + NB * LRU_SEG + 32) { const int j = bid - 96 - NB * LRU_SEG; s5_scan(p, l, j >> 2, j & 3, lds, wv); role_done(p, le, j >> 2, 0, wv); }
    gdn_helper_loop(p, l, le, lds, wv);
    finalize_loop(p, l, le, lds, wv);
}

#define XB_TMO      128
#define XB_XCNT(j)  (256  + 64 * (j))
#define XB_XSUB(j)  (1280 + 64 * (j))
#define XB_XGEN(j)  (2304 + 64 * (j))
#define XB_TOP      3328
#define XB_TOPGEN   3392
#define XCD_BAR_WORDS 3456
#define XB_SPIN_CAP (1u << 18)

__device__ __forceinline__ unsigned xb_ld(unsigned* p)              { return __hip_atomic_load(p, __ATOMIC_RELAXED, __HIP_MEMORY_SCOPE_AGENT); }
__device__ __forceinline__ unsigned xb_add(unsigned* p, unsigned v) { return __hip_atomic_fetch_add(p, v, __ATOMIC_RELAXED, __HIP_MEMORY_SCOPE_AGENT); }
__device__ __forceinline__ unsigned xb_xcc_id() { return (unsigned)__builtin_amdgcn_s_getreg((3 << 11) | 20) & 0xFu; }
#define XB_SPIN(cond, bar) do { unsigned _sp = 0; while (cond) { __builtin_amdgcn_s_sleep(1); \
    if ((++_sp & 255u) == 0u) { if (xb_ld(&(bar)[XB_TMO])) break; if (_sp > XB_SPIN_CAP) { atomicAdd(&(bar)[XB_TMO], 1u); break; } } } } while (0)

struct XcdBarrier {
    unsigned* bar; unsigned x;
    volatile LAS unsigned* st;
};

__device__ __forceinline__ XcdBarrier xcd_barrier_post(unsigned* bar, volatile LAS unsigned* st, bool is0) {
    XcdBarrier b; b.bar = bar; b.x = xb_xcc_id(); b.st = st;
    if (is0) (void)xb_add(&bar[XB_XCNT(b.x)], 1u);
    return b;
}
__device__ __forceinline__ void xcd_barrier_complete(unsigned* bar, unsigned x, unsigned& nloc, unsigned& nx) {
    const unsigned G = gridDim.x * gridDim.y * gridDim.z;
    unsigned sum, cnt, mine, sp = 0u;
    for (;;) {
        sum = 0u; cnt = 0u; mine = 0u;
#pragma unroll
        for (unsigned j = 0; j < 16; ++j) { const unsigned c = xb_ld(&bar[XB_XCNT(j)]); sum += c; cnt += (c > 0u) ? 1u : 0u; mine = (j == x) ? c : mine; }
        if (sum == G) break;
        __builtin_amdgcn_s_sleep(1);
        if ((++sp & 255u) == 0u) { if (xb_ld(&bar[XB_TMO])) break; if (sp > XB_SPIN_CAP) { atomicAdd(&bar[XB_TMO], 1u); break; } }
    }
    nloc = mine > 0u ? mine : 1u; nx = cnt > 0u ? cnt : 1u;
}

__device__ __forceinline__ void xcd_barrier(const XcdBarrier& b, bool is0) {
    asm volatile("s_waitcnt vmcnt(0)" ::: "memory");
    __syncthreads();
    if (is0) {
        unsigned* bar = b.bar;
        __builtin_amdgcn_s_waitcnt(0);
        unsigned nloc = b.st[0], nx = b.st[1];
        if (nloc == 0u) { xcd_barrier_complete(bar, b.x, nloc, nx); b.st[0] = nloc; b.st[1] = nx; }
        const unsigned old = xb_add(&bar[XB_XSUB(b.x)], 1u);
        const unsigned gen = old / nloc;
        if (old + 1u == (gen + 1u) * nloc) {
            __builtin_amdgcn_fence(__ATOMIC_RELEASE, "agent");
            asm volatile("s_waitcnt vmcnt(0)" ::: "memory");
            const unsigned og = xb_add(&bar[XB_TOP], 1u);
            const unsigned tg = og / nx;
            if (og + 1u == (tg + 1u) * nx) xb_add(&bar[XB_TOPGEN], 1u);
            else XB_SPIN(xb_ld(&bar[XB_TOPGEN]) == tg, bar);
            __builtin_amdgcn_fence(__ATOMIC_ACQUIRE, "agent");
            xb_add(&bar[XB_XGEN(b.x)], 1u);
            asm volatile("s_waitcnt vmcnt(0)" ::: "memory");
        } else {
            XB_SPIN(xb_ld(&bar[XB_XGEN(b.x)]) == gen, bar);
            __builtin_amdgcn_fence(__ATOMIC_ACQUIRE, "agent");
            asm volatile("s_waitcnt vmcnt(0)" ::: "memory");
        }
    }
    __syncthreads();
}


__global__ void __launch_bounds__(NTHREADS, 2) fwd_megakernel(Params p_) {
    extern __shared__ __attribute__((aligned(16))) unsigned char lds_raw[];
    LAS unsigned char* lds = (LAS unsigned char*)lds_raw;
    cg::grid_group grid = cg::this_grid();
    const int wv = __builtin_amdgcn_readfirstlane((int)threadIdx.x >> 6);
    const Params& p = *(const Params*)__builtin_amdgcn_kernarg_segment_ptr();
    (void)p_;
    typedef const __attribute__((address_space(4))) Params* ParamsK;
    unsigned char* ws = ((ParamsK)__builtin_amdgcn_kernarg_segment_ptr())->ws;
    unsigned* barw = (unsigned*)(ws + WS_BAR);
    { const int t0 = opaque_tid(wv);
      if (opaque_s(blockIdx.x) == 0) for (int i = t0; i < XCD_BAR_WORDS; i += NTHREADS) __hip_atomic_store(barw + i, 0u, __ATOMIC_RELAXED, __HIP_MEMORY_SCOPE_AGENT);
      if (opaque_s(blockIdx.x) == 1) for (int i = t0; i < 2048; i += NTHREADS) __hip_atomic_store((unsigned*)(ws + WS_FLAG) + i, 0u, __ATOMIC_RELAXED, __HIP_MEMORY_SCOPE_AGENT);
      if (t0 < 4) ((LAS unsigned*)(lds + LDS_BYTES - 16))[t0] = 0u; }
    grid.sync();
    const XcdBarrier xbar = xcd_barrier_post(barw, (volatile LAS unsigned*)(lds + LDS_BYTES - 16), opaque_tid(wv) == 0);
    for (int ph = 0; ph < NL * 10; ++ph) {
        const int l = ph / 10, k = ph % 10;
        const int G = opaque_s(gridDim.x), bid = opaque_s(blockIdx.x);
        unsigned char* wsl = ((ParamsK)__builtin_amdgcn_kernarg_segment_ptr())->ws;
        float* H = (float*)(wsl + WS_H); bf16_t* XN = (bf16_t*)(wsl + WS_XN); bf16_t* W = (bf16_t*)(wsl + WS_W);
        bf16_t* ACT = (bf16_t*)(wsl + WS_ACT); bf16_t* PROJ = (bf16_t*)(wsl + WS_PROJ); float* SM = (float*)(wsl + WS_SM); bf16_t* Y = (bf16_t*)(wsl + WS_Y);
        if (k == 0) {
            convert_layer(p, l, lds, bid, G, wv);
            if (l == 0) norm_phase<true>(p, p.in[I_F1N], wv, 0); else norm_phase<false>(p, p.in[I_F1N] + (size_t)l * DM, wv, DFF / 256);
        } else if (k == 3) {
            norm_phase<false>(p, p.in[I_MIXN] + (size_t)l * DM, wv, DFF / 256);
        } else if (k == 7) {
            norm_phase<false>(p, p.in[I_F2N] + (size_t)l * DM, wv, DMIX / 256);
        } else if (k == 5) {
            for (int rep = 0, nrep = opaque_s(MIXREP); rep < nrep; ++rep) { mixer_phase(p, l, l * MIXREP + rep, lds, bid, wv); if (rep + 1 < nrep) xcd_barrier(xbar, opaque_tid(wv) == 0); }
        } else {
            const bool isGU = (k == 1 || k == 8), isDN = (k == 2 || k == 9), isIN = (k == 4);
            const bf16_t* gA = (isGU || isIN) ? XN : (isDN ? ACT : Y);
            const size_t wo = isGU ? (k == 1 ? W_GU1 : W_GU2) : (isDN ? (k == 2 ? W_DN1 : W_DN2) : (isIN ? W_IN : W_OUT));
            const int gN = isGU ? 2 * DFF : (isIN ? NPJ : DM), gK = isDN ? DFF : ((isGU || isIN) ? DM : DMIX);
            const int emode = isGU ? 0 : (isIN ? 2 : 1);
            const pg8::Gemm g{gA, W + wo, MP, gN, gK};
            const pg8::Epi E{emode, emode != 1, isGU ? ACT : PROJ, isIN ? SM : H, isDN ? 0.5f : 1.0f, gK / 64};
            pg8::StaticOrder S; S.init(MP, gN, gK, G, bid, emode == 1);
            pg8::gemm_phase(lds, g, S, E, wv);
        }
        xcd_barrier(xbar, opaque_tid(wv) == 0);
    }
    final_phase(p, wv);
}

extern "C" void kernel_launch(void* const* d_in, const int* in_sizes, int n_in, void* d_out, int out_size, void* d_ws, size_t ws_size, hipStream_t stream) {
    static int grid = 0;
    if (grid == 0) {
        if (n_in != N_INPUTS || ws_size < WS_END) { fprintf(stderr, "kernel_launch: unexpected n_in %d or ws_size %zu (< %zu)\n", n_in, ws_size, (size_t)WS_END); }
        int dev = 0, cus = 0, per_cu = 0;
        (void)hipGetDevice(&dev);
        (void)hipDeviceGetAttribute(&cus, hipDeviceAttributeMultiprocessorCount, dev);
        (void)hipFuncSetAttribute((const void*)fwd_megakernel, hipFuncAttributeMaxDynamicSharedMemorySize, LDS_BYTES);
        (void)hipOccupancyMaxActiveBlocksPerMultiprocessor(&per_cu, (const void*)fwd_megakernel, NTHREADS, LDS_BYTES);
        if (per_cu < 1) { fprintf(stderr, "kernel_launch: occupancy query says %d blocks per CU\n", per_cu); per_cu = 1; }
        (void)hipGetLastError();
        grid = cus;
    }
    Params p{};
    for (int i = 0; i < N_INPUTS; ++i) p.in[i] = (const float*)d_in[i];
    p.out = (float*)d_out; p.ws = (unsigned char*)d_ws;
    void* args[] = {&p};
    hipError_t e = hipLaunchCooperativeKernel((const void*)fwd_megakernel, dim3(grid), dim3(NTHREADS), args, LDS_BYTES, stream);
    if (e != hipSuccess) fprintf(stderr, "cooperative launch failed: %s (grid %d)\n", hipGetErrorString(e), grid);
}
```
